# Optimizing an MI355X kernel written in HIP

```python
import math
import jax, jax.numpy as jnp
from jax import lax
import numpy as np

D_MODEL = 1024
BATCH = 2
SEQ = 16384
DEPTH = 4

CHUNK = 128
A_GROUPS = 4
A_CH = 128
A_WIDTH = A_GROUPS * A_CH
B_GROUPS = 4
B_WIDTH = 512
CONV_W = 3
MIX_IN = 2 * A_WIDTH + 3 * B_WIDTH
MIX_OUT = A_WIDTH + B_WIDTH
N_HEADS = 16
N_KV = 2
HEAD_DIM = 64
GQA_GROUP = N_HEADS // N_KV
WINDOW = 128
QKV_DIM = (N_HEADS + 2 * N_KV) * HEAD_DIM
ATT_OUT = N_HEADS * HEAD_DIM
N_BUCKETS = 32
MAX_DISTANCE = 128
N_GROUPS = 4
EXPERTS_PER_GROUP = 8
N_EXPERTS = N_GROUPS * EXPERTS_PER_GROUP
TOP_K = 2
D_EXPERT = 512
ROW_BLOCK = 128
ALPHA = (2 * DEPTH) ** 0.25
BETA = (8 * DEPTH) ** -0.25
LN_EPS = 1e-5
N_EVEN = (DEPTH + 1) // 2
N_ODD = DEPTH // 2

kernel_name = 'hybrid_gmlp_conv_swa_hmoe_deepnorm'


def layer_norm(x, g, b):
    xf = x.astype(jnp.float32)
    mu = jnp.mean(xf, axis=-1, keepdims=True)
    var = jnp.mean(jnp.square(xf - mu), axis=-1, keepdims=True)
    y = (xf - mu) * lax.rsqrt(var + LN_EPS)
    return (y * g.astype(jnp.float32) + b.astype(jnp.float32)).astype(x.dtype)


def t5_bucket(rel):
    n = jnp.maximum(rel, 0)
    max_exact = N_BUCKETS // 2
    nf = jnp.maximum(n, 1).astype(jnp.float32)
    large = max_exact + (jnp.log(nf / max_exact) / math.log(MAX_DISTANCE / max_exact)
                         * (N_BUCKETS - max_exact)).astype(jnp.int32)
    large = jnp.minimum(large, N_BUCKETS - 1)
    return jnp.where(n < max_exact, n, large)


def gating_conv_mixer(x, w_in, ln_g, ln_b, w_sp, b_sp, conv_w, w_out):
    bsz, s, _ = x.shape
    h = x @ w_in
    u = jax.nn.gelu(h[..., :A_WIDTH], approximate=False)
    v = jax.nn.gelu(h[..., A_WIDTH:2 * A_WIDTH], approximate=False)
    o = 2 * A_WIDTH
    g_b = h[..., o:o + B_WIDTH]
    g_c = h[..., o + B_WIDTH:o + 2 * B_WIDTH]
    hb = h[..., o + 2 * B_WIDTH:o + 3 * B_WIDTH]
    v = layer_norm(v, ln_g, ln_b)
    v = v.reshape(bsz, s // CHUNK, CHUNK, A_GROUPS, A_CH)
    causal = jnp.tril(jnp.ones((CHUNK, CHUNK), dtype=bool))
    ws = jnp.where(causal[None], w_sp, 0)
    sv = jnp.einsum('gij,bnjgc->bnigc', ws, v) + b_sp.T[:, :, None]
    y_a = u * sv.reshape(bsz, s, A_WIDTH)
    z = g_c * hb
    zp = jnp.pad(z, ((0, 0), (CONV_W - 1, 0), (0, 0)))
    conv = conv_w[0] * zp[:, 0:s]
    for k in range(1, CONV_W):
        conv = conv + conv_w[k] * zp[:, k:k + s]
    y_b = g_b * conv
    return jnp.concatenate([y_a, y_b], axis=-1) @ w_out


def sliding_window_attention(x, w_qkv, b_qkv, sinks, w_o, b_o, rel_table):
    bsz, s, _ = x.shape
    nb = s // CHUNK
    qkv = x @ w_qkv + b_qkv
    q = qkv[..., :ATT_OUT] * (HEAD_DIM ** -0.5)
    k = qkv[..., ATT_OUT:ATT_OUT + N_KV * HEAD_DIM].reshape(bsz, s, N_KV, HEAD_DIM)
    v = qkv[..., ATT_OUT + N_KV * HEAD_DIM:].reshape(bsz, s, N_KV, HEAD_DIM)
    q = q.reshape(bsz, nb, CHUNK, N_KV, GQA_GROUP, HEAD_DIM)

    def band(t):
        tp = jnp.pad(t, ((0, 0), (CHUNK, 0), (0, 0), (0, 0)))
        tp = tp.reshape(bsz, nb + 1, CHUNK, N_KV, HEAD_DIM)
        return jnp.concatenate([tp[:, :-1], tp[:, 1:]], axis=2)

    kw, vw = band(k), band(v)
    a = jnp.arange(CHUNK)[:, None]
    c = jnp.arange(2 * CHUNK)[None, :]
    rel = a + CHUNK - c
    bias = rel_table[t5_bucket(rel)].astype(jnp.float32)
    bias = jnp.transpose(bias, (2, 0, 1)).reshape(N_KV, GQA_GROUP, CHUNK, 2 * CHUNK)
    win = (rel >= 0) & (rel < WINDOW)
    key_pos = jnp.arange(nb)[:, None, None] * CHUNK - CHUNK + c[None]
    mask = win[None] & (key_pos >= 0)

    sc = jnp.einsum('bnqkgd,bnckd->bnkgqc', q, kw).astype(jnp.float32) + bias
    sc = jnp.where(mask[None, :, None, None], sc, jnp.finfo(jnp.float32).min)
    sink = sinks.astype(jnp.float32).reshape(1, 1, N_KV, GQA_GROUP, 1)
    m = jnp.maximum(jnp.max(sc, axis=-1), sink)
    p = jnp.exp(sc - m[..., None])
    denom = jnp.sum(p, axis=-1) + jnp.exp(sink - m)
    probs = (p / denom[..., None]).astype(vw.dtype)
    o = jnp.einsum('bnkgqc,bnckd->bnqkgd', probs, vw).reshape(bsz, s, ATT_OUT)
    return o @ w_o + b_o


def hierarchical_moe(x, w_grp, w_exp, wg, wu, wd):
    bsz, s, d = x.shape
    t = bsz * s
    xf = x.reshape(t, d)
    g_logits = (xf @ w_grp).astype(jnp.float32)
    g_prob = jax.nn.softmax(g_logits, axis=-1)
    g_idx = jnp.argmax(g_logits, axis=-1)
    g_p = jnp.take_along_axis(g_prob, g_idx[:, None], axis=1)[:, 0]
    e_logits = (xf @ w_exp).astype(jnp.float32).reshape(t, N_GROUPS, EXPERTS_PER_GROUP)
    e_sel = jnp.take_along_axis(e_logits, g_idx[:, None, None], axis=1)[:, 0]
    e_prob = jax.nn.softmax(e_sel, axis=-1)
    top_p, top_i = lax.top_k(e_prob, TOP_K)
    top_p = top_p / jnp.sum(top_p, axis=-1, keepdims=True)
    gates = (g_p[:, None] * top_p).reshape(-1)
    eid = (g_idx[:, None] * EXPERTS_PER_GROUP + top_i).reshape(-1).astype(jnp.int32)
    tok = jnp.repeat(jnp.arange(t, dtype=jnp.int32), TOP_K)
    n = t * TOP_K
    counts = jnp.zeros((N_EXPERTS,), jnp.int32).at[eid].add(1)
    padded = (counts + ROW_BLOCK - 1) // ROW_BLOCK * ROW_BLOCK
    pad_end = jnp.cumsum(padded)
    pad_start = pad_end - padded
    start = jnp.cumsum(counts) - counts
    order = jnp.argsort(eid, stable=True)
    se = eid[order]
    dest = pad_start[se] + jnp.arange(n, dtype=jnp.int32) - start[se]
    p_rows = n + N_EXPERTS * ROW_BLOCK
    nblk = p_rows // ROW_BLOCK
    row_tok = jnp.full((p_rows,), t, jnp.int32).at[dest].set(tok[order])
    row_gate = jnp.zeros((p_rows,), jnp.float32).at[dest].set(gates[order])
    blk_e = jnp.minimum(jnp.searchsorted(pad_end, jnp.arange(nblk, dtype=jnp.int32) * ROW_BLOCK,
                                         side='right'), N_EXPERTS - 1)
    xs = jnp.concatenate([xf, jnp.zeros((1, d), xf.dtype)], axis=0)[row_tok]
    xs = xs.reshape(nblk, ROW_BLOCK, d)

    def run_block(args):
        xb, e = args
        hid = jax.nn.silu(xb @ wg[e]) * (xb @ wu[e])
        return hid @ wd[e]

    ys = lax.map(run_block, (xs, blk_e)).reshape(p_rows, d)
    out = jax.ops.segment_sum(ys * row_gate[:, None].astype(ys.dtype), row_tok,
                              num_segments=t + 1)[:t]
    return out.reshape(bsz, s, d)


def setup_inputs(seed: int = 0) -> dict:
    key = jax.random.key(seed)
    ks = jax.random.split(key, 24)
    f32 = jnp.float32

    def nrm(k, shape, scale):
        return jax.random.normal(k, shape, f32) * scale

    return {
        'x': nrm(ks[0], (BATCH, SEQ, D_MODEL), 1.0),
        'rel_bias_table': nrm(ks[1], (N_BUCKETS, N_HEADS), 0.2),
        'mix_w_in': nrm(ks[2], (N_EVEN, D_MODEL, MIX_IN), D_MODEL ** -0.5),
        'gmlp_ln_g': 1.0 + nrm(ks[3], (N_EVEN, A_WIDTH), 0.02),
        'gmlp_ln_b': nrm(ks[4], (N_EVEN, A_WIDTH), 0.02),
        'gmlp_w_spatial': nrm(ks[5], (N_EVEN, A_GROUPS, CHUNK, CHUNK), 0.5 * CHUNK ** -0.5),
        'gmlp_b_spatial': 1.0 + nrm(ks[6], (N_EVEN, A_GROUPS, CHUNK), 0.02),
        'conv_w': nrm(ks[7], (N_EVEN, CONV_W, B_WIDTH), CONV_W ** -0.5),
        'mix_w_out': nrm(ks[8], (N_EVEN, MIX_OUT, D_MODEL), BETA * MIX_OUT ** -0.5),
        'attn_w_qkv': nrm(ks[9], (N_ODD, D_MODEL, QKV_DIM), D_MODEL ** -0.5),
        'attn_b_qkv': nrm(ks[10], (N_ODD, QKV_DIM), 0.02),
        'attn_sinks': nrm(ks[11], (N_ODD, N_HEADS), 0.5),
        'attn_w_o': nrm(ks[12], (N_ODD, ATT_OUT, D_MODEL), BETA * ATT_OUT ** -0.5),
        'attn_b_o': nrm(ks[13], (N_ODD, D_MODEL), 0.02),
        'ln1_g': 1.0 + nrm(ks[14], (DEPTH, D_MODEL), 0.02),
        'ln1_b': nrm(ks[15], (DEPTH, D_MODEL), 0.02),
        'ln2_g': 1.0 + nrm(ks[16], (DEPTH, D_MODEL), 0.02),
        'ln2_b': nrm(ks[17], (DEPTH, D_MODEL), 0.02),
        'router_group': nrm(ks[18], (DEPTH, D_MODEL, N_GROUPS), D_MODEL ** -0.5),
        'router_expert': nrm(ks[19], (DEPTH, D_MODEL, N_EXPERTS), D_MODEL ** -0.5),
        'expert_w_gate': nrm(ks[20], (DEPTH, N_EXPERTS, D_MODEL, D_EXPERT), D_MODEL ** -0.5),
        'expert_w_up': nrm(ks[21], (DEPTH, N_EXPERTS, D_MODEL, D_EXPERT), D_MODEL ** -0.5),
        'expert_w_down': nrm(ks[22], (DEPTH, N_EXPERTS, D_EXPERT, D_MODEL), BETA * D_EXPERT ** -0.5),
    }


def reference(x, rel_bias_table, mix_w_in, gmlp_ln_g, gmlp_ln_b, gmlp_w_spatial,
              gmlp_b_spatial, conv_w, mix_w_out, attn_w_qkv, attn_b_qkv, attn_sinks,
              attn_w_o, attn_b_o, ln1_g, ln1_b, ln2_g, ln2_b, router_group,
              router_expert, expert_w_gate, expert_w_up, expert_w_down):
    for l in range(DEPTH):
        i = l // 2
        if l % 2 == 0:
            m = gating_conv_mixer(x, mix_w_in[i], gmlp_ln_g[i], gmlp_ln_b[i],
                                  gmlp_w_spatial[i], gmlp_b_spatial[i], conv_w[i],
                                  mix_w_out[i])
        else:
            m = sliding_window_attention(x, attn_w_qkv[i], attn_b_qkv[i], attn_sinks[i],
                                         attn_w_o[i], attn_b_o[i], rel_bias_table)
        x = layer_norm(ALPHA * x + m, ln1_g[l], ln1_b[l])
        f = hierarchical_moe(x, router_group[l], router_expert[l], expert_w_gate[l],
                             expert_w_up[l], expert_w_down[l])
        x = layer_norm(ALPHA * x + f, ln2_g[l], ln2_b[l])
    return x
```

```cpp
#include <hip/hip_runtime.h>
#include <cstdio>
#include <cstdint>
#ifndef PH_P0
#define PH_P0 1
#endif
#ifndef PH_E1
#define PH_E1 1
#endif
#ifndef PH_E2
#define PH_E2 1
#endif
#ifndef PH_E3
#define PH_E3 1
#endif
#ifndef PH_A1
#define PH_A1 1
#endif
#ifndef PH_A2
#define PH_A2 1
#endif
#ifndef PH_A3
#define PH_A3 1
#endif
#ifndef PH_L1
#define PH_L1 1
#endif
#ifndef PH_M1
#define PH_M1 1
#endif
#ifndef PH_M2
#define PH_M2 1
#endif
#ifndef PH_L2
#define PH_L2 1
#endif

constexpr int T_TOK = 32768, SEQ = 16384, DM = 1024, NLAYER = 4;
constexpr int MIXIN = 2560, QKVD = 1280, DEXP = 512, NEXP = 32;
constexpr float ALPHA = 1.681792830507429f;
constexpr float LN_EPS = 1e-5f;

namespace pg8 {
#define PG8_LAS __attribute__((address_space(3)))
typedef unsigned short bf16_t;
typedef short bf16x8 __attribute__((ext_vector_type(8)));
typedef float f32x4 __attribute__((ext_vector_type(4)));
typedef float f32x2 __attribute__((ext_vector_type(2)));
typedef unsigned u32x4 __attribute__((ext_vector_type(4)));
constexpr int BM = 256, BK = 64, HALF = 128, HTB = HALF * BK * 2  , STAGE_BYTES = 8 * HTB, NXCD = 8, WGM = 8;

__host__ __device__ __forceinline__ int lds_byte(int r, int c) { const int st = (r >> 4) * 2 + (c >> 5), rr = r & 15, cc = c & 31, ob = rr * 64 + cc * 2; return st * 1024 + (ob ^ (((ob >> 9) & 1) << 5)); }
__host__ __device__ __forceinline__ void stage_rc(int b, int& R, int& C) { const int st = b / 1024, sb = b % 1024, swz = sb ^ (((sb >> 9) & 1) << 5); R = (st >> 1) * 16 + swz / 64; C = (st & 1) * 32 + (swz % 64) / 2; }
__host__ __device__ __forceinline__ int perm32(int rho) { const int n = rho >> 4, i = rho & 15; return 8 * (i >> 2) + 4 * n + (i & 3); }

struct Unit { int pm, pn, e, lbase, rows; };
struct Gemm { const bf16_t* A; const bf16_t* Bt; size_t bstride; const unsigned* list; };

struct StaticOrder {
    int nM, nN, nwg, G, c;
    __device__ void init(int M, int N, int G_, int c_) { nM = M / BM; nN = N / BM; nwg = nM * nN; G = G_; c = c_; }
    __device__ bool next(int i, Unit& u) const {
        const long L = (long)i * G + c; if (L >= nwg) return false;
        int wgid = (int)L; { const int q = nwg / NXCD, r = nwg % NXCD, xcd = wgid % NXCD, off = wgid / NXCD; wgid = (xcd < r ? xcd * (q + 1) : r * (q + 1) + (xcd - r) * q) + off; }
        const int nig = WGM * nN, gid = wgid / nig, fm = gid * WGM, gsz = (nM - fm) < WGM ? (nM - fm) : WGM;
        u.pm = fm + ((wgid % nig) % gsz); u.pn = (wgid % nig) / gsz; u.e = 0; u.lbase = 0; u.rows = BM; return true;
    }
};
struct MoeOrder {
    const PG8_LAS int* bst; int total, G, c;
    __device__ bool next(int i, Unit& u) const {
        const int L = i * G + c; if (L >= total * 4) return false;
        const int blk = L >> 2; int e = 0;
#pragma unroll
        for (int k = 1; k < 32; ++k) e += (bst[k] <= blk) ? 1 : 0;
        e = __builtin_amdgcn_readfirstlane(e);
        const int rb = blk - __builtin_amdgcn_readfirstlane(bst[e]); const int cnt = __builtin_amdgcn_readfirstlane(bst[64 + e]);
        int rows = cnt - rb * BM; rows = rows > BM ? BM : rows;
        u.pm = blk; u.pn = L & 3; u.e = e; u.lbase = e * T_TOK + rb * BM; u.rows = rows; return true;
    }
};

__device__ __forceinline__ unsigned cvt_pk_bf16(float lo, float hi) { unsigned r; asm volatile("v_cvt_pk_bf16_f32 %0, %1, %2" : "=v"(r) : "v"(lo), "v"(hi)); return r; }
__device__ __forceinline__ f32x2 gelu_pk(f32x2 v) {
    const f32x2 av = __builtin_elementwise_abs(v), d = av * 0.2316418882f + 1.0f;
    f32x2 t; t.x = __builtin_amdgcn_rcpf(d.x); t.y = __builtin_amdgcn_rcpf(d.y);
    f32x2 q = t * 0.5307027145f + (-0.7265760135f); q = q * t + 0.7107068705f; q = q * t + (-0.142248368f); q = q * t + 0.127414796f; q = q * t;
    const f32x2 s = (v * v) * (-0.72134752044f);
    f32x2 e; e.x = __builtin_amdgcn_exp2f(s.x); e.y = __builtin_amdgcn_exp2f(s.y);
    const f32x2 m = v * (q * e), r = v - m;
    f32x2 o; o.x = v.x < 0.f ? m.x : r.x; o.y = v.y < 0.f ? m.y : r.y; return o;
}
__device__ __forceinline__ u32x4 pack8(f32x4 v0, f32x4 v1) { u32x4 w; w.x = cvt_pk_bf16(v0[0], v0[1]); w.y = cvt_pk_bf16(v0[2], v0[3]); w.z = cvt_pk_bf16(v1[0], v1[1]); w.w = cvt_pk_bf16(v1[2], v1[3]); return w; }

struct EpiH {
    static constexpr bool PERM = true;
    bf16_t* O;
    __device__ __forceinline__ void operator()(const f32x4 (&acc)[2][2][4][2], const Unit& u, int wr, int wc, int fr, int fq) const {
        const int row0 = u.pm * BM + wr * 64 + fr, col0 = u.pn * BM + wc * 32 + 8 * fq; const bool act = u.pn < 4;
#pragma unroll
        for (int ai = 0; ai < 2; ++ai)
#pragma unroll
            for (int m = 0; m < 4; ++m) { bf16_t* rowp = O + (size_t)(row0 + ai * HALF + m * 16) * MIXIN + col0;
#pragma unroll
                for (int bj = 0; bj < 2; ++bj) { f32x4 v0 = acc[ai][bj][m][0], v1 = acc[ai][bj][m][1];
                    if (act) { f32x2 a = gelu_pk((f32x2){v0[0], v0[1]}), b = gelu_pk((f32x2){v0[2], v0[3]}), c = gelu_pk((f32x2){v1[0], v1[1]}), d = gelu_pk((f32x2){v1[2], v1[3]});
                        v0 = (f32x4){a.x, a.y, b.x, b.y}; v1 = (f32x4){c.x, c.y, d.x, d.y}; }
                    *(u32x4*)(rowp + bj * HALF) = pack8(v0, v1); } }
    }
};
struct EpiQKV {
    static constexpr bool PERM = true;
    bf16_t* Q; bf16_t* Kb; bf16_t* Vt; const float* bias;
    __device__ __forceinline__ void operator()(const f32x4 (&acc)[2][2][4][2], const Unit& u, int wr, int wc, int fr, int fq) const {
        const int row0 = u.pm * BM + wr * 64 + fr, cw = wc * 32 + 8 * fq;
        f32x4 bv[2][2];
#pragma unroll
        for (int bj = 0; bj < 2; ++bj)
#pragma unroll
            for (int n = 0; n < 2; ++n) bv[bj][n] = *(const f32x4*)(bias + u.pn * BM + bj * HALF + cw + 4 * n);
        if (u.pn < 4) {
#pragma unroll
            for (int ai = 0; ai < 2; ++ai)
#pragma unroll
                for (int m = 0; m < 4; ++m) { bf16_t* rowp = Q + (size_t)(row0 + ai * HALF + m * 16) * DM + u.pn * BM + cw;
#pragma unroll
                    for (int bj = 0; bj < 2; ++bj) *(u32x4*)(rowp + bj * HALF) = pack8((acc[ai][bj][m][0] + bv[bj][0]) * 0.125f, (acc[ai][bj][m][1] + bv[bj][1]) * 0.125f); }
        } else {
#pragma unroll
            for (int ai = 0; ai < 2; ++ai)
#pragma unroll
                for (int m = 0; m < 4; ++m) { const int row = row0 + ai * HALF + m * 16;
                    *(u32x4*)(Kb + (size_t)row * 128 + cw) = pack8(acc[ai][0][m][0] + bv[0][0], acc[ai][0][m][1] + bv[0][1]);
                    bf16_t* vrow = Vt + ((size_t)((row >> 14) * 128 + cw)) * SEQ + (row & (SEQ - 1));
#pragma unroll
                    for (int n = 0; n < 2; ++n) { const f32x4 v = acc[ai][1][m][n] + bv[1][n];
#pragma unroll
                        for (int j = 0; j < 4; ++j) vrow[(size_t)(4 * n + j) * SEQ] = (bf16_t)(cvt_pk_bf16(v[j], 0.f) & 0xffffu); }
                    asm volatile("" ::: "memory"); }
        }
    }
};
struct EpiRes {
    static constexpr bool PERM = false;
    const float* xres; float* R; const float* bias;
    __device__ __forceinline__ void operator()(const f32x4 (&acc)[2][2][4][2], const Unit& u, int wr, int wc, int fr, int fq) const {
        const int row0 = u.pm * BM + wr * 64 + fr, col0 = u.pn * BM + wc * 32 + 4 * fq;
        f32x4 bv[2][2];
#pragma unroll
        for (int bj = 0; bj < 2; ++bj)
#pragma unroll
            for (int n = 0; n < 2; ++n) bv[bj][n] = bias ? *(const f32x4*)(bias + col0 + bj * HALF + n * 16) : (f32x4){0.f, 0.f, 0.f, 0.f};
#pragma unroll
        for (int ai = 0; ai < 2; ++ai)
#pragma unroll
            for (int m = 0; m < 4; ++m) { const size_t off = (size_t)(row0 + ai * HALF + m * 16) * DM + col0;
#pragma unroll
                for (int bj = 0; bj < 2; ++bj)
#pragma unroll
                    for (int n = 0; n < 2; ++n) { const f32x4 xr = *(const f32x4*)(xres + off + bj * HALF + n * 16);
                        *(f32x4*)(R + off + bj * HALF + n * 16) = xr * ALPHA + acc[ai][bj][m][n] + bv[bj][n]; }
                if (m & 1) asm volatile("" ::: "memory"); }
    }
};
struct EpiHid {
    static constexpr bool PERM = true;
    bf16_t* hid;
    __device__ __forceinline__ float silu(float g) const { return g * __builtin_amdgcn_rcpf(1.0f + __expf(-g)); }
    __device__ __forceinline__ void operator()(const f32x4 (&acc)[2][2][4][2], const Unit& u, int wr, int wc, int fr, int fq) const {
        const int row0 = u.pm * BM + wr * 64 + fr, col0 = u.pn * HALF + wc * 32 + 8 * fq;
#pragma unroll
        for (int ai = 0; ai < 2; ++ai)
#pragma unroll
            for (int m = 0; m < 4; ++m) { f32x4 h0, h1;
#pragma unroll
                for (int j = 0; j < 4; ++j) { h0[j] = silu(acc[ai][0][m][0][j]) * acc[ai][1][m][0][j]; h1[j] = silu(acc[ai][0][m][1][j]) * acc[ai][1][m][1][j]; }
                *(u32x4*)(hid + (size_t)(row0 + ai * HALF + m * 16) * DEXP + col0) = pack8(h0, h1); }
    }
};
struct EpiScatter {
    static constexpr bool PERM = true;
    bf16_t* yb; const unsigned* ltok; const float* lgate;
    __device__ __forceinline__ void operator()(const f32x4 (&acc)[2][2][4][2], const Unit& u, int wr, int wc, int fr, int fq) const {
        const int col0 = u.pn * BM + wc * 32 + 8 * fq;
#pragma unroll
        for (int ai = 0; ai < 2; ++ai)
#pragma unroll
            for (int m = 0; m < 4; ++m) { const int r = ai * HALF + wr * 64 + m * 16 + fr;
                if (r < u.rows) { const unsigned ent = ltok[u.lbase + r]; const float gt = lgate[u.lbase + r];
                    bf16_t* dst = yb + ((size_t)(ent >> 31) * T_TOK + (ent & 0x7fffffffu)) * DM + col0;
#pragma unroll
                    for (int bj = 0; bj < 2; ++bj) *(u32x4*)(dst + bj * HALF) = pack8(acc[ai][bj][m][0] * gt, acc[ai][bj][m][1] * gt); } }
    }
};

__device__ __forceinline__ void gather_offs(const PG8_LAS unsigned* tab, int rows, const int (&Rr)[2], const unsigned (&cb)[2], unsigned rowbytes, unsigned (&v0)[2], unsigned (&v1)[2]) {
#pragma unroll
    for (int i = 0; i < 2; ++i) { unsigned t0 = tab[Rr[i]] & 0x7fffffffu, t1 = tab[HALF + Rr[i]] & 0x7fffffffu;
        t0 = Rr[i] < rows ? t0 : 0u; t1 = (HALF + Rr[i]) < rows ? t1 : 0u;
        v0[i] = t0 * rowbytes + cb[i]; v1[i] = t1 * rowbytes + cb[i]; }
}

template <class Epi, class Sched, bool GATHER, int K>
__device__ __forceinline__ void gemm_phase(PG8_LAS unsigned char* lds, PG8_LAS unsigned* tab, const Gemm g, const Sched& S, const Epi& E) {
    int tid_ = threadIdx.x; asm volatile("" : "+v"(tid_));
    const int tid = tid_, wid = __builtin_amdgcn_readfirstlane(tid >> 6), lane = tid & 63, wr = wid >> 2, wc = wid & 3, fr = lane & 15, fq = lane >> 4;
    constexpr int nt = K / BK;
    int Rr[2]; unsigned cb[2], voffB[2], vC0[2], vC1[2], vN0[2], vN1[2];
#pragma unroll
    for (int i = 0; i < 2; ++i) { int R, C; stage_rc(tid * 16 + i * 8192, R, C); const int Rb = Epi::PERM ? ((R & ~31) + perm32(R & 31)) : R;
        Rr[i] = R; cb[i] = (unsigned)C * 2u; voffB[i] = (unsigned)(Rb * K + C) * 2u;
        vC0[i] = (unsigned)(R * K + C) * 2u; vC1[i] = (unsigned)((R + HALF) * K + C) * 2u; vN0[i] = vC0[i]; vN1[i] = vC1[i]; }
    constexpr size_t kstep = (size_t)(BK * 2);
    constexpr size_t hstep = (size_t)HALF * K * 2;
    constexpr size_t tstep = 2 * hstep;
    const unsigned ldsw = (unsigned)wid * 1024u;
    const int aoff = lds_byte(wr * 64 + fr, fq * 8), boff = lds_byte(wc * 32 + fr, fq * 8);
#define PG8_SA(b, h) (((b) * 2 + (h)) * HTB)
#define PG8_SB(b, h) ((4 + (b) * 2 + (h)) * HTB)
#define PG8_STAGE(bufoff, gbase, voff) do { _Pragma("unroll") for (int _i = 0; _i < 2; ++_i) \
        __builtin_amdgcn_global_load_lds((const unsigned*)((const char*)(gbase) + (voff)[_i]), (PG8_LAS unsigned*)(lds + (bufoff) + ldsw + _i * 8192), 16, 0, 0); } while (0)
#define PG8_LDA(dst, b, h) do { _Pragma("unroll") for (int m = 0; m < 4; ++m) _Pragma("unroll") for (int k = 0; k < 2; ++k) dst[m][k] = *(const PG8_LAS bf16x8*)(lds + PG8_SA(b, h) + aoff + m * 2048 + k * 1024); } while (0)
#define PG8_LDB(dst, b, h) do { _Pragma("unroll") for (int n = 0; n < 2; ++n) _Pragma("unroll") for (int k = 0; k < 2; ++k) dst[n][k] = *(const PG8_LAS bf16x8*)(lds + PG8_SB(b, h) + boff + n * 2048 + k * 1024); } while (0)
#define PG8_MMA(ai, bj, At, Bt) do { __builtin_amdgcn_s_setprio(1); _Pragma("unroll") for (int m = 0; m < 4; ++m) _Pragma("unroll") for (int n = 0; n < 2; ++n) _Pragma("unroll") for (int k = 0; k < 2; ++k) \
        acc[ai][bj][m][n] = __builtin_amdgcn_mfma_f32_16x16x32_bf16(Bt[n][k], At[m][k], acc[ai][bj][m][n], 0, 0, 0); __builtin_amdgcn_s_setprio(0); } while (0)
#define PG8_WAIT_V(n) asm volatile("s_waitcnt vmcnt(" #n ")" ::: "memory")
#define PG8_WAIT_L(n) asm volatile("s_waitcnt lgkmcnt(" #n ")" ::: "memory")
#define PG8_BAR __builtin_amdgcn_s_barrier()
#define PG8_SCHED __builtin_amdgcn_sched_barrier(0)
    Unit cur, nxt; int ui = 0;
    if (!S.next(0, cur)) return;
    f32x4 acc[2][2][4][2];
#pragma unroll
    for (int a = 0; a < 2; ++a)
#pragma unroll
        for (int b = 0; b < 2; ++b)
#pragma unroll
            for (int m = 0; m < 4; ++m)
#pragma unroll
                for (int n = 0; n < 2; ++n) acc[a][b][m][n] = (f32x4){0.f, 0.f, 0.f, 0.f};
    bf16x8 At[4][2], B0[2][2], B1[2][2];
    if constexpr (GATHER) {
        if (wid == 0) { __builtin_amdgcn_global_load_lds(g.list + cur.lbase + lane * 4, tab, 16, 0, 0); asm volatile("s_waitcnt vmcnt(0)" ::: "memory"); }
        __syncthreads();
        gather_offs(tab, cur.rows, Rr, cb, (unsigned)(K * 2), vC0, vC1);
    }
    const char* cA = GATHER ? (const char*)g.A : (const char*)g.A + (size_t)cur.pm * tstep;
    const char* cB = (const char*)g.Bt + (size_t)cur.e * g.bstride + (size_t)cur.pn * tstep;
    PG8_STAGE(PG8_SB(0, 0), cB, voffB); PG8_STAGE(PG8_SB(0, 1), cB + hstep, voffB); PG8_STAGE(PG8_SA(0, 0), cA, vC0); PG8_STAGE(PG8_SA(0, 1), cA, vC1);
    if (wr == 1) PG8_BAR;
    PG8_WAIT_V(2); PG8_BAR;
    PG8_STAGE(PG8_SB(1, 0), cB + kstep, voffB); PG8_STAGE(PG8_SA(1, 0), cA + kstep, vC0); PG8_STAGE(PG8_SB(1, 1), cB + hstep + kstep, voffB);
    PG8_WAIT_V(6); PG8_BAR;
    for (;;) {
        const bool has_next = S.next(ui + 1, nxt);
        if constexpr (GATHER) { if (has_next && wid == 0) __builtin_amdgcn_global_load_lds(g.list + nxt.lbase + lane * 4, tab + ((ui + 1) & 1) * 256, 16, 0, 0); }
        const char* nA = GATHER ? (const char*)g.A : (has_next ? (const char*)g.A + (size_t)nxt.pm * tstep : cA);
        const char* nB = has_next ? (const char*)g.Bt + (size_t)nxt.e * g.bstride + (size_t)nxt.pn * tstep : cB;
        for (int t = 0; t < nt; t += 2) {
            const bool last = (t == nt - 2);
            if constexpr (GATHER) { if (last && has_next) gather_offs(tab + ((ui + 1) & 1) * 256, nxt.rows, Rr, cb, (unsigned)(K * 2), vN0, vN1); }
            unsigned w0[2], w1[2];
#pragma unroll
            for (int i = 0; i < 2; ++i) { w0[i] = last ? vN0[i] : vC0[i]; w1[i] = last ? vN1[i] : vC1[i]; }
            const char* a1 = cA + (size_t)(t + 1) * kstep;
            const char* a2 = last ? nA : cA + (size_t)(t + 2) * kstep; const char* b2 = last ? nB : cB + (size_t)(t + 2) * kstep;
            const char* a3 = a2 + kstep; const char* b3 = b2 + kstep;
            PG8_LDB(B0, 0, 0); PG8_LDB(B1, 0, 1); PG8_SCHED; PG8_LDA(At, 0, 0); PG8_STAGE(PG8_SA(1, 1), a1, vC1);
            PG8_WAIT_V(8); PG8_WAIT_L(0); PG8_BAR; PG8_MMA(0, 0, At, B0); PG8_MMA(0, 1, At, B1); PG8_BAR; PG8_SCHED;
            PG8_LDA(At, 0, 1); PG8_STAGE(PG8_SB(0, 0), b2, voffB); PG8_STAGE(PG8_SB(0, 1), b2 + hstep, voffB); PG8_STAGE(PG8_SA(0, 0), a2, w0);
            PG8_WAIT_V(8); PG8_WAIT_L(0); PG8_BAR; PG8_MMA(1, 0, At, B0); PG8_MMA(1, 1, At, B1); PG8_BAR; PG8_SCHED;
            PG8_LDB(B0, 1, 0); PG8_LDB(B1, 1, 1); PG8_SCHED; PG8_LDA(At, 1, 0); PG8_STAGE(PG8_SA(0, 1), a2, w1);
            PG8_WAIT_V(8); PG8_WAIT_L(0); PG8_BAR; PG8_MMA(0, 0, At, B0); PG8_MMA(0, 1, At, B1); PG8_BAR; PG8_SCHED;
            PG8_LDA(At, 1, 1); PG8_STAGE(PG8_SB(1, 0), b3, voffB); PG8_STAGE(PG8_SB(1, 1), b3 + hstep, voffB); PG8_STAGE(PG8_SA(1, 0), a3, w0);
            PG8_WAIT_V(8); PG8_WAIT_L(0); PG8_BAR; PG8_MMA(1, 0, At, B0); PG8_MMA(1, 1, At, B1); PG8_BAR; PG8_SCHED;
        }
        if (wr == 0) PG8_BAR;
        E(acc, cur, wr, wc, fr, fq);
        if (!has_next) break;
#pragma unroll
        for (int a = 0; a < 2; ++a)
#pragma unroll
            for (int b = 0; b < 2; ++b)
#pragma unroll
                for (int m = 0; m < 4; ++m)
#pragma unroll
                    for (int n = 0; n < 2; ++n) acc[a][b][m][n] = (f32x4){0.f, 0.f, 0.f, 0.f};
        cur = nxt; cA = nA; cB = nB; ++ui;
#pragma unroll
        for (int i = 0; i < 2; ++i) { vC0[i] = vN0[i]; vC1[i] = vN1[i]; }
        if (wr == 1) PG8_BAR;
    }
    PG8_WAIT_V(0);
    PG8_BAR;
#undef PG8_SA
#undef PG8_SB
#undef PG8_STAGE
#undef PG8_LDA
#undef PG8_LDB
#undef PG8_MMA
#undef PG8_WAIT_V
#undef PG8_WAIT_L
#undef PG8_BAR
#undef PG8_SCHED
}
}

constexpr size_t MiB = 1u << 20;
constexpr size_t WS_CTL = 0, CTL_ZERO_BYTES = 1 * MiB;
constexpr size_t WS_WIN = 1 * MiB;
constexpr size_t WS_WOUT = WS_WIN + 10 * MiB;
constexpr size_t WS_WQKV = WS_WOUT + 4 * MiB;
constexpr size_t WS_WO = WS_WQKV + 5 * MiB;
constexpr size_t WS_RTR = WS_WO + 4 * MiB;
constexpr size_t WS_LTOK = WS_RTR + 1 * MiB;
constexpr size_t WS_LGATE = WS_LTOK + 4 * MiB;
constexpr size_t WS_W1 = WS_LGATE + 4 * MiB;
constexpr size_t WS_W2 = WS_W1 + 256 * MiB;
constexpr size_t WS_XB = WS_W2 + 128 * MiB;
constexpr size_t WS_H = WS_XB + 64 * MiB;
constexpr size_t WS_Y = WS_H + 160 * MiB;
constexpr size_t WS_HID = WS_Y + 64 * MiB;
constexpr size_t WS_END = WS_HID + 72 * MiB;
constexpr size_t WS_QB = WS_H, WS_KB = WS_H + 64 * MiB, WS_VT = WS_KB + 8 * MiB;
constexpr int CW_TMO = 0;
constexpr int CW_BAR = 4096;
constexpr int CW_CNT = 8192;
static_assert((CW_CNT + 128) * 4 <= (int)CTL_ZERO_BYTES, "ctl");

constexpr int RING_BYTES = 131072;
constexpr int TAB_OFF = RING_BYTES;
constexpr int BST_OFF = TAB_OFF + 2048;
constexpr int MISC_OFF = BST_OFF + 512;
constexpr int LDS_BYTES = 147456;
static_assert(MISC_OFF + 128 <= LDS_BYTES, "LDS map");

#define GAS __attribute__((address_space(1)))
#define LAS __attribute__((address_space(3)))
typedef unsigned short bf16;
typedef unsigned v4u __attribute__((ext_vector_type(4)));
typedef unsigned v2u __attribute__((ext_vector_type(2)));
typedef float f32x4 __attribute__((ext_vector_type(4)));
typedef float f32x16 __attribute__((ext_vector_type(16)));
typedef short bf16x8 __attribute__((ext_vector_type(8)));
#define LDS_WAIT() asm volatile("s_waitcnt lgkmcnt(0)" ::: "memory")
__device__ __forceinline__ unsigned f2bf(float f) { unsigned u = __builtin_bit_cast(unsigned, f); return (u + 0x7fffu + ((u >> 16) & 1u)) >> 16; }
__device__ __forceinline__ unsigned pk2(float lo, float hi) { return f2bf(lo) | (f2bf(hi) << 16); }
__device__ __forceinline__ float bflo(unsigned w) { return __builtin_bit_cast(float, w << 16); }
__device__ __forceinline__ float bfhi(unsigned w) { return __builtin_bit_cast(float, w & 0xffff0000u); }

#define XB_TMO      128
#define XB_XCNT(j)  (256  + 64 * (j))
#define XB_XSUB(j)  (1280 + 64 * (j))
#define XB_XGEN(j)  (2304 + 64 * (j))
#define XB_TOP      3328
#define XB_TOPGEN   3392
#define XCD_BAR_WORDS 3456
#define XB_SPIN_CAP (1u << 18)

__device__ __forceinline__ unsigned xb_ld(unsigned* p)              { return __hip_atomic_load(p, __ATOMIC_RELAXED, __HIP_MEMORY_SCOPE_AGENT); }
__device__ __forceinline__ unsigned xb_add(unsigned* p, unsigned v) { return __hip_atomic_fetch_add(p, v, __ATOMIC_RELAXED, __HIP_MEMORY_SCOPE_AGENT); }
__device__ __forceinline__ unsigned xb_xcc_id() { return (unsigned)__builtin_amdgcn_s_getreg((3 << 11) | 20) & 0xFu; }
#define XB_SPIN(cond, bar) do { unsigned _sp = 0; while (cond) { __builtin_amdgcn_s_sleep(1); \
    if ((++_sp & 255u) == 0u) { if (xb_ld(&(bar)[XB_TMO])) break; if (_sp > XB_SPIN_CAP) { atomicAdd(&(bar)[XB_TMO], 1u); break; } } } } while (0)

struct XcdBarrier {
    unsigned* bar; unsigned x;
    volatile LAS unsigned* st;
};
__device__ __forceinline__ XcdBarrier xcd_barrier_post(unsigned* bar, volatile LAS unsigned* st) {
    XcdBarrier b; b.bar = bar; b.x = xb_xcc_id(); b.st = st;
    if (threadIdx.x == 0) (void)xb_add(&bar[XB_XCNT(b.x)], 1u);
    return b;
}
__device__ __forceinline__ void xcd_barrier_complete(unsigned* bar, unsigned x, unsigned& nloc, unsigned& nx) {
    const unsigned G = gridDim.x * gridDim.y * gridDim.z;
    unsigned sum, cnt, mine, sp = 0u;
    for (;;) {
        sum = 0u; cnt = 0u; mine = 0u;
#pragma unroll
        for (unsigned j = 0; j < 16; ++j) { const unsigned c = xb_ld(&bar[XB_XCNT(j)]); sum += c; cnt += (c > 0u) ? 1u : 0u; mine = (j == x) ? c : mine; }
        if (sum == G) break;
        __builtin_amdgcn_s_sleep(1);
        if ((++sp & 255u) == 0u) { if (xb_ld(&bar[XB_TMO])) break; if (sp > XB_SPIN_CAP) { atomicAdd(&bar[XB_TMO], 1u); break; } }
    }
    nloc = mine > 0u ? mine : 1u; nx = cnt > 0u ? cnt : 1u;
}
__device__ __forceinline__ void xcd_barrier(const XcdBarrier& b) {
    asm volatile("s_waitcnt vmcnt(0)" ::: "memory");
    __syncthreads();
    if (threadIdx.x == 0) {
        unsigned* bar = b.bar;
        __builtin_amdgcn_s_waitcnt(0);
        unsigned nloc = b.st[0], nx = b.st[1];
        if (nloc == 0u) { xcd_barrier_complete(bar, b.x, nloc, nx); b.st[0] = nloc; b.st[1] = nx; }
        const unsigned old = xb_add(&bar[XB_XSUB(b.x)], 1u);
        const unsigned gen = old / nloc;
        if (old + 1u == (gen + 1u) * nloc) {
            __builtin_amdgcn_fence(__ATOMIC_RELEASE, "agent");
            asm volatile("s_waitcnt vmcnt(0)" ::: "memory");
            const unsigned og = xb_add(&bar[XB_TOP], 1u);
            const unsigned tg = og / nx;
            if (og + 1u == (tg + 1u) * nx) xb_add(&bar[XB_TOPGEN], 1u);
            else XB_SPIN(xb_ld(&bar[XB_TOPGEN]) == tg, bar);
            __builtin_amdgcn_fence(__ATOMIC_ACQUIRE, "agent");
            xb_add(&bar[XB_XGEN(b.x)], 1u);
            asm volatile("s_waitcnt vmcnt(0)" ::: "memory");
        } else {
            XB_SPIN(xb_ld(&bar[XB_XGEN(b.x)]) == gen, bar);
            __builtin_amdgcn_fence(__ATOMIC_ACQUIRE, "agent");
            asm volatile("s_waitcnt vmcnt(0)" ::: "memory");
        }
    }
    __syncthreads();
}

struct Args {
    const float* x; const float* rel_table; const float* mix_w_in; const float* gmlp_ln_g; const float* gmlp_ln_b; const float* gmlp_w_sp; const float* gmlp_b_sp;
    const float* conv_w; const float* mix_w_out; const float* attn_w_qkv; const float* attn_b_qkv; const float* attn_sinks; const float* attn_w_o; const float* attn_b_o;
    const float* ln1_g; const float* ln1_b; const float* ln2_g; const float* ln2_b; const float* router_group; const float* router_expert;
    const float* w_gate; const float* w_up; const float* w_down;
    float* out; unsigned char* ws;
};

typedef const __attribute__((address_space(4))) Args* ArgsCP;
#define ARGS_PTR() ({ ArgsCP p_ = (ArgsCP)__builtin_amdgcn_kernarg_segment_ptr(); asm volatile("" : "+s"(p_)); p_; })
struct Frame {
    LAS unsigned char* lds;
    int tid, lane, wave, G, bid;
};
#define FRAME_REFRESH(F) do { int t_ = threadIdx.x; asm volatile("" : "+v"(t_)); (F).tid = t_; (F).lane = t_ & 63; (F).wave = __builtin_amdgcn_readfirstlane(t_ >> 6); } while (0)

__device__ __forceinline__ float wave_sum(float v) {
#pragma unroll
    for (int o = 1; o < 64; o <<= 1) v += __shfl_xor(v, o);
    return v;
}

__device__ const unsigned char T5_BUCKET[128] = {0, 1, 2, 3, 4, 5, 6, 7, 8, 9, 10, 11, 12, 13, 14, 15, 16, 16, 16, 17, 17, 18, 18, 18, 19, 19, 19, 20, 20, 20, 20, 21, 21, 21, 21, 22, 22, 22, 22, 22, 23, 23, 23, 23, 23, 23, 24, 24, 24, 24, 24, 24, 25, 25, 25, 25, 25, 25, 25, 26, 26, 26, 26, 26, 26, 26, 26, 27, 27, 27, 27, 27, 27, 27, 27, 27, 27, 28, 28, 28, 28, 28, 28, 28, 28, 28, 28, 29, 29, 29, 29, 29, 29, 29, 29, 29, 29, 29, 29, 30, 30, 30, 30, 30, 30, 30, 30, 30, 30, 30, 30, 30, 30, 31, 31, 31, 31, 31, 31, 31, 31, 31, 31, 31, 31, 31, 31, 31};

__device__ __forceinline__ void p0_item(const float* W, int N, bf16* WT, int dstK, int dst_row0, LAS float* scr, int kb, int nb, int lane) {
    const int k0 = 64 * kb, n0 = 32 * nb;
#pragma unroll 8
    for (int i = 0; i < 32; ++i) { const int kk = 2 * i + (lane >> 5); scr[kk * 33 + (lane & 31)] = W[(size_t)(k0 + kk) * N + n0 + (lane & 31)]; }
    LDS_WAIT(); asm volatile("" ::: "memory");
    const int c = lane & 7;
#pragma unroll
    for (int j = 0; j < 4; ++j) { const int n = (lane >> 3) + 8 * j; const LAS float* s = scr + (8 * c) * 33 + n;
        v4u o; o.x = pk2(s[0 * 33], s[1 * 33]); o.y = pk2(s[2 * 33], s[3 * 33]); o.z = pk2(s[4 * 33], s[5 * 33]); o.w = pk2(s[6 * 33], s[7 * 33]);
        *(GAS v4u*)(WT + (size_t)(dst_row0 + n) * dstK + k0 + 8 * c) = o; }
    LDS_WAIT(); asm volatile("" ::: "memory");
}
__device__ __forceinline__ void phase_prologue(ArgsCP A, Frame F) {
    FRAME_REFRESH(F);
    LAS float* scr = (LAS float*)(F.lds + F.wave * 16384);
    const int gw = F.bid * 8 + F.wave, NGW = F.G * 8;
    constexpr int I_IN = 16 * 80, I_OUT = 16 * 32, I_QKV = 16 * 40, I_O = 16 * 32, I_SMALL = 2 * (I_IN + I_OUT + I_QKV + I_O), I_EXP = NLAYER * NEXP * 768;
    bf16* WIN = (bf16*)(A->ws + WS_WIN); bf16* WOUT = (bf16*)(A->ws + WS_WOUT); bf16* WQKV = (bf16*)(A->ws + WS_WQKV); bf16* WO = (bf16*)(A->ws + WS_WO);
    bf16* W1 = (bf16*)(A->ws + WS_W1); bf16* W2 = (bf16*)(A->ws + WS_W2);
    for (int it = gw; it < I_SMALL + I_EXP; it += NGW) {
        if (it < I_SMALL) {
            int r = it; const int i = r / (I_SMALL / 2); r -= i * (I_SMALL / 2);
            if (r < I_IN) { const int nbk = 80; p0_item(A->mix_w_in + (size_t)i * DM * MIXIN, MIXIN, WIN + (size_t)i * MIXIN * DM, DM, 32 * (r % nbk), scr, r / nbk, r % nbk, F.lane); continue; } r -= I_IN;
            if (r < I_OUT) { const int nbk = 32; p0_item(A->mix_w_out + (size_t)i * DM * DM, DM, WOUT + (size_t)i * DM * DM, DM, 32 * (r % nbk), scr, r / nbk, r % nbk, F.lane); continue; } r -= I_OUT;
            if (r < I_QKV) { const int nbk = 40; p0_item(A->attn_w_qkv + (size_t)i * DM * QKVD, QKVD, WQKV + (size_t)i * QKVD * DM, DM, 32 * (r % nbk), scr, r / nbk, r % nbk, F.lane); continue; } r -= I_QKV;
            { const int nbk = 32; p0_item(A->attn_w_o + (size_t)i * DM * DM, DM, WO + (size_t)i * DM * DM, DM, 32 * (r % nbk), scr, r / nbk, r % nbk, F.lane); }
        } else {
            const int r = it - I_SMALL, le = r / 768, q = r % 768, ty = q >> 8, item = q & 255;
            if (ty < 2) {
                const int kb = item >> 4, nb = item & 15, n0 = 32 * nb;
                p0_item((ty == 0 ? A->w_gate : A->w_up) + (size_t)le * DM * DEXP, DEXP, W1 + (size_t)le * DM * DM, DM, 256 * (n0 >> 7) + (n0 & 127) + 128 * ty, scr, kb, nb, F.lane);
            } else {
                const int kb = item >> 5, nb = item & 31;
                p0_item(A->w_down + (size_t)le * DEXP * DM, DM, W2 + (size_t)le * DM * DEXP, DEXP, 32 * nb, scr, kb, nb, F.lane);
            }
        }
    }
    bf16* XB = (bf16*)(A->ws + WS_XB);
    for (int m = gw; m < T_TOK; m += NGW) {
        const GAS f32x4* xr = (const GAS f32x4*)(A->x + (size_t)m * DM) + F.lane; GAS v2u* o = (GAS v2u*)(XB + (size_t)m * DM) + F.lane;
#pragma unroll
        for (int j = 0; j < 4; ++j) { const f32x4 v = xr[64 * j]; v2u w; w.x = pk2(v.x, v.y); w.y = pk2(v.z, v.w); o[64 * j] = w; }
    }
    bf16* RTR = (bf16*)(A->ws + WS_RTR);
    for (int idx = F.bid * 512 + F.tid; idx < NLAYER * 48 * 1024; idx += F.G * 512) {
        const int k = idx & 1023, n = (idx >> 10) % 48, l = idx / (48 * 1024);
        float w = 0.f;
        if (n < 4) w = A->router_group[((size_t)l * DM + k) * 4 + n]; else if (n < 36) w = A->router_expert[((size_t)l * DM + k) * 32 + (n - 4)];
        const unsigned hi = f2bf(w); const unsigned lo = f2bf(w - __builtin_bit_cast(float, hi << 16));
        RTR[((size_t)(l * 2 + 0) * 48 + n) * 1024 + k] = (bf16)hi; RTR[((size_t)(l * 2 + 1) * 48 + n) * 1024 + k] = (bf16)lo;
    }
}

__device__ __forceinline__ void phase_gmlp(ArgsCP A, Frame F, int li) {
    FRAME_REFRESH(F);
    const bf16* H = (const bf16*)(A->ws + WS_H); bf16* Y = (bf16*)(A->ws + WS_Y);
    const float* lng = A->gmlp_ln_g + li * 512; const float* lnb = A->gmlp_ln_b + li * 512;
    const float* wsp = A->gmlp_w_sp + (size_t)li * 4 * 128 * 128; const float* bsp = A->gmlp_b_sp + li * 4 * 128; const float* cw = A->conv_w + li * 3 * 512;
    LAS float* stat = (LAS float*)(F.lds);
    LAS unsigned char* VnT = F.lds + 1024;
    LAS unsigned char* WsL = F.lds + 1024 + 34816;
    const int lane = F.lane, wave = F.wave, tid = F.tid;
    for (int ch = F.bid; ch < T_TOK / 128; ch += F.G) {
        const int t0 = ch * 128;
        for (int rr = 0; rr < 16; ++rr) {
            const int rl = 16 * wave + rr;
            const v4u pk = *(const GAS v4u*)(H + (size_t)(t0 + rl) * MIXIN + 512 + lane * 8);
            float v[8] = {bflo(pk.x), bfhi(pk.x), bflo(pk.y), bfhi(pk.y), bflo(pk.z), bfhi(pk.z), bflo(pk.w), bfhi(pk.w)};
            float s = 0.f;
#pragma unroll
            for (int e = 0; e < 8; ++e) s += v[e];
            const float mean = wave_sum(s) * (1.f / 512.f); float q = 0.f;
#pragma unroll
            for (int e = 0; e < 8; ++e) { const float d = v[e] - mean; q += d * d; }
            const float rstd = 1.f / sqrtf(wave_sum(q) * (1.f / 512.f) + LN_EPS);
            if (lane == 0) { stat[2 * rl] = mean; stat[2 * rl + 1] = rstd; }
        }
        {
            const int c0 = 8 * lane, rstart = t0 + 16 * wave;
            float w0[8], w1[8], w2[8], z1[8], z2[8];
#pragma unroll
            for (int e = 0; e < 8; ++e) { w0[e] = cw[c0 + e]; w1[e] = cw[512 + c0 + e]; w2[e] = cw[1024 + c0 + e]; z1[e] = 0.f; z2[e] = 0.f; }
            if ((rstart & (SEQ - 1)) != 0) {
#pragma unroll
                for (int dr = 2; dr >= 1; --dr) {
                    const bf16* hr = H + (size_t)(rstart - dr) * MIXIN;
                    const v4u gc = *(const GAS v4u*)(hr + 1536 + c0), hb = *(const GAS v4u*)(hr + 2048 + c0);
                    float z[8] = {bflo(gc.x) * bflo(hb.x), bfhi(gc.x) * bfhi(hb.x), bflo(gc.y) * bflo(hb.y), bfhi(gc.y) * bfhi(hb.y), bflo(gc.z) * bflo(hb.z), bfhi(gc.z) * bfhi(hb.z), bflo(gc.w) * bflo(hb.w), bfhi(gc.w) * bfhi(hb.w)};
#pragma unroll
                    for (int e = 0; e < 8; ++e) { if (dr == 2) z2[e] = z[e]; else z1[e] = z[e]; }
                }
            }
            for (int dr = 0; dr < 16; ++dr) {
                const bf16* hr = H + (size_t)(rstart + dr) * MIXIN;
                const v4u gb = *(const GAS v4u*)(hr + 1024 + c0), gc = *(const GAS v4u*)(hr + 1536 + c0), hb = *(const GAS v4u*)(hr + 2048 + c0);
                float z[8] = {bflo(gc.x) * bflo(hb.x), bfhi(gc.x) * bfhi(hb.x), bflo(gc.y) * bflo(hb.y), bfhi(gc.y) * bfhi(hb.y), bflo(gc.z) * bflo(hb.z), bfhi(gc.z) * bfhi(hb.z), bflo(gc.w) * bflo(hb.w), bfhi(gc.w) * bfhi(hb.w)};
                float g[8] = {bflo(gb.x), bfhi(gb.x), bflo(gb.y), bfhi(gb.y), bflo(gb.z), bfhi(gb.z), bflo(gb.w), bfhi(gb.w)};
                float y[8];
#pragma unroll
                for (int e = 0; e < 8; ++e) { y[e] = g[e] * (w0[e] * z2[e] + w1[e] * z1[e] + w2[e] * z[e]); z2[e] = z1[e]; z1[e] = z[e]; }
                v4u o; o.x = pk2(y[0], y[1]); o.y = pk2(y[2], y[3]); o.z = pk2(y[4], y[5]); o.w = pk2(y[6], y[7]);
                *(GAS v4u*)(Y + (size_t)(rstart + dr) * DM + 512 + c0) = o;
            }
        }
        __syncthreads();
        for (int g = 0; g < 4; ++g) {
            {
                const int j = tid >> 2, part = tid & 3; const float mean = stat[2 * j], rstd = stat[2 * j + 1];
#pragma unroll
                for (int q4 = 0; q4 < 4; ++q4) {
                    const int cbase = 32 * part + 8 * q4;
                    const v4u pk = *(const GAS v4u*)(H + (size_t)(t0 + j) * MIXIN + 512 + 128 * g + cbase);
                    float v[8] = {bflo(pk.x), bfhi(pk.x), bflo(pk.y), bfhi(pk.y), bflo(pk.z), bfhi(pk.z), bflo(pk.w), bfhi(pk.w)};
#pragma unroll
                    for (int e = 0; e < 8; ++e) { const int c = cbase + e; const float val = (v[e] - mean) * rstd * lng[128 * g + c] + lnb[128 * g + c];
                        *(LAS unsigned short*)(VnT + c * 272 + j * 2) = (unsigned short)f2bf(val); }
                }
                const int i = tid >> 2, jb = (tid & 3) * 32;
                const float* wrow = wsp + ((size_t)g * 128 + i) * 128 + jb;
#pragma unroll
                for (int q4 = 0; q4 < 4; ++q4) {
                    const f32x4 a = *(const GAS f32x4*)(wrow + 8 * q4), b = *(const GAS f32x4*)(wrow + 8 * q4 + 4);
                    float w[8] = {a.x, a.y, a.z, a.w, b.x, b.y, b.z, b.w};
#pragma unroll
                    for (int e = 0; e < 8; ++e) w[e] = (jb + 8 * q4 + e <= i) ? w[e] : 0.f;
                    v4u o; o.x = pk2(w[0], w[1]); o.y = pk2(w[2], w[3]); o.z = pk2(w[4], w[5]); o.w = pk2(w[6], w[7]);
                    *(LAS v4u*)(WsL + i * 272 + (jb + 8 * q4) * 2) = o;
                }
            }
            __syncthreads();
            {
                const int it = wave >> 1, cts = 2 * (wave & 1), r32 = lane & 31, hl = lane >> 5;
                f32x16 acc0, acc1;
#pragma unroll
                for (int e = 0; e < 16; ++e) { acc0[e] = 0.f; acc1[e] = 0.f; }
                const int nks = 2 * (it + 1);
                for (int ks = 0; ks < nks; ++ks) {
                    const bf16x8 b = *(const LAS bf16x8*)(WsL + (32 * it + r32) * 272 + (16 * ks + 8 * hl) * 2);
                    const bf16x8 a0 = *(const LAS bf16x8*)(VnT + (32 * cts + r32) * 272 + (16 * ks + 8 * hl) * 2);
                    const bf16x8 a1 = *(const LAS bf16x8*)(VnT + (32 * (cts + 1) + r32) * 272 + (16 * ks + 8 * hl) * 2);
                    acc0 = __builtin_amdgcn_mfma_f32_32x32x16_bf16(a0, b, acc0, 0, 0, 0);
                    acc1 = __builtin_amdgcn_mfma_f32_32x32x16_bf16(a1, b, acc1, 0, 0, 0);
                }
                const int i = 32 * it + r32; const size_t row = (size_t)(t0 + i); const float bs = bsp[g * 128 + i];
#pragma unroll
                for (int ct2 = 0; ct2 < 2; ++ct2)
#pragma unroll
                    for (int q = 0; q < 4; ++q) {
                        const int c0 = 32 * (cts + ct2) + 8 * q + 4 * hl;
                        const v2u up = *(const GAS v2u*)(H + row * MIXIN + 128 * g + c0);
                        const float a0_ = ct2 ? acc1[4 * q + 0] : acc0[4 * q + 0], a1_ = ct2 ? acc1[4 * q + 1] : acc0[4 * q + 1], a2_ = ct2 ? acc1[4 * q + 2] : acc0[4 * q + 2], a3_ = ct2 ? acc1[4 * q + 3] : acc0[4 * q + 3];
                        v2u o; o.x = pk2(bflo(up.x) * (a0_ + bs), bfhi(up.x) * (a1_ + bs)); o.y = pk2(bflo(up.y) * (a2_ + bs), bfhi(up.y) * (a3_ + bs));
                        *(GAS v2u*)(Y + row * DM + 128 * g + c0) = o;
                    }
            }
            __syncthreads();
        }
    }
}

__device__ __forceinline__ void phase_attn(ArgsCP A, Frame F, int li) {
    FRAME_REFRESH(F);
    const bf16* Q = (const bf16*)(A->ws + WS_QB); const bf16* Kb = (const bf16*)(A->ws + WS_KB); const bf16* Vt = (const bf16*)(A->ws + WS_VT); bf16* Y = (bf16*)(A->ws + WS_Y);
    LAS unsigned char* Ks = F.lds;
    LAS unsigned char* Vs = F.lds + 36864;
    LAS float* bias = (LAS float*)(F.lds + 36864 + 33792);
    const int lane = F.lane, wave = F.wave, tid = F.tid;
    for (int idx = tid; idx < 2048; idx += 512) { const int h = idx >> 7, rel = idx & 127; bias[idx] = A->rel_table[(int)T5_BUCKET[rel] * 16 + h]; }
    const float* sinks = A->attn_sinks + li * 16;
    for (int u = F.bid; u < 512; u += F.G) {
        const int kvh = u & 1, nb = (u >> 1) & 127, b = u >> 8;
        __syncthreads();
#pragma unroll
        for (int q = 0; q < 4; ++q) {
            const int idx = tid + 512 * q;
            { const int c = idx >> 3, part = idx & 7; v4u val = (v4u){0u, 0u, 0u, 0u};
              if (nb > 0 || c >= 128) val = *(const GAS v4u*)(Kb + ((size_t)b * SEQ + (size_t)((nb - 1) * 128 + c)) * 128 + kvh * 64 + part * 8);
              *(LAS v4u*)(Ks + c * 144 + part * 16) = val; }
            { const int d = idx >> 5, part = idx & 31; v4u val = (v4u){0u, 0u, 0u, 0u};
              if (nb > 0 || part >= 16) val = *(const GAS v4u*)(Vt + ((size_t)((b * 2 + kvh) * 64 + d)) * SEQ + (nb - 1) * 128 + part * 8);
              *(LAS v4u*)(Vs + d * 528 + part * 16) = val; }
        }
        __syncthreads();
        const int hh = kvh * 8 + wave, r32 = lane & 31, hl = lane >> 5; const float sink = sinks[hh];
        for (int sb = 0; sb < 4; ++sb) {
            const int a0 = 32 * sb; const size_t qrow = (size_t)b * SEQ + nb * 128 + a0 + r32;
            bf16x8 qf[4];
#pragma unroll
            for (int ks = 0; ks < 4; ++ks) qf[ks] = *(const GAS bf16x8*)(Q + qrow * DM + hh * 64 + 16 * ks + 8 * hl);
            f32x16 S[5];
#pragma unroll
            for (int k5 = 0; k5 < 5; ++k5) {
#pragma unroll
                for (int e = 0; e < 16; ++e) S[k5][e] = 0.f;
#pragma unroll
                for (int ks = 0; ks < 4; ++ks) { const bf16x8 a = *(const LAS bf16x8*)(Ks + (32 * (sb + k5) + r32) * 144 + (16 * ks + 8 * hl) * 2);
                    S[k5] = __builtin_amdgcn_mfma_f32_32x32x16_bf16(a, qf[ks], S[k5], 0, 0, 0); }
            }
            const int a = a0 + r32; float mx = sink;
#pragma unroll
            for (int k5 = 0; k5 < 5; ++k5)
#pragma unroll
                for (int e = 0; e < 16; ++e) { const int c = 32 * (sb + k5) + (e & 3) + 8 * (e >> 2) + 4 * hl; const int rel = a + 128 - c;
                    const bool valid = (rel >= 0) && (rel < 128) && (nb > 0 || c >= 128);
                    const float sc = valid ? S[k5][e] + bias[hh * 128 + (rel & 127)] : -1e30f; S[k5][e] = sc; mx = fmaxf(mx, sc); }
            mx = fmaxf(mx, __shfl_xor(mx, 32));
            float sum = 0.f;
#pragma unroll
            for (int k5 = 0; k5 < 5; ++k5)
#pragma unroll
                for (int e = 0; e < 16; ++e) { const float p = __expf(S[k5][e] - mx); S[k5][e] = p; sum += p; }
            sum += __shfl_xor(sum, 32);
            const float inv = 1.f / (sum + __expf(sink - mx));
            f32x16 O0, O1;
#pragma unroll
            for (int e = 0; e < 16; ++e) { O0[e] = 0.f; O1[e] = 0.f; }
#pragma unroll
            for (int k5 = 0; k5 < 5; ++k5)
#pragma unroll
                for (int s = 0; s < 2; ++s) {
                    v4u pw; pw.x = pk2(S[k5][8 * s + 0], S[k5][8 * s + 1]); pw.y = pk2(S[k5][8 * s + 2], S[k5][8 * s + 3]); pw.z = pk2(S[k5][8 * s + 4], S[k5][8 * s + 5]); pw.w = pk2(S[k5][8 * s + 6], S[k5][8 * s + 7]);
                    const bf16x8 pf = __builtin_bit_cast(bf16x8, pw);
                    const int kc = 32 * (sb + k5) + 16 * s + 4 * hl;
                    { const v2u lo = *(const LAS v2u*)(Vs + r32 * 528 + kc * 2), hi = *(const LAS v2u*)(Vs + r32 * 528 + (kc + 8) * 2);
                      const v4u av = (v4u){lo.x, lo.y, hi.x, hi.y}; O0 = __builtin_amdgcn_mfma_f32_32x32x16_bf16(__builtin_bit_cast(bf16x8, av), pf, O0, 0, 0, 0); }
                    { const v2u lo = *(const LAS v2u*)(Vs + (32 + r32) * 528 + kc * 2), hi = *(const LAS v2u*)(Vs + (32 + r32) * 528 + (kc + 8) * 2);
                      const v4u av = (v4u){lo.x, lo.y, hi.x, hi.y}; O1 = __builtin_amdgcn_mfma_f32_32x32x16_bf16(__builtin_bit_cast(bf16x8, av), pf, O1, 0, 0, 0); }
                }
            bf16* orow = Y + qrow * DM + hh * 64;
#pragma unroll
            for (int qd = 0; qd < 4; ++qd) {
                const int d0 = 8 * qd + 4 * hl;
                v2u o0; o0.x = pk2(O0[4 * qd + 0] * inv, O0[4 * qd + 1] * inv); o0.y = pk2(O0[4 * qd + 2] * inv, O0[4 * qd + 3] * inv);
                v2u o1; o1.x = pk2(O1[4 * qd + 0] * inv, O1[4 * qd + 1] * inv); o1.y = pk2(O1[4 * qd + 2] * inv, O1[4 * qd + 3] * inv);
                *(GAS v2u*)(orow + d0) = o0; *(GAS v2u*)(orow + 32 + d0) = o1;
            }
        }
    }
    __syncthreads();
}

__device__ __forceinline__ void phase_ln1(ArgsCP A, Frame F, int l) {
    FRAME_REFRESH(F);
    const float* R = (const float*)(A->ws + WS_H); float* x = A->out; bf16* XB = (bf16*)(A->ws + WS_XB);
    const float* g = A->ln1_g + l * DM; const float* bb = A->ln1_b + l * DM;
    const bf16* RH = (const bf16*)(A->ws + WS_RTR) + (size_t)(l * 2 + 0) * 48 * 1024; const bf16* RL = (const bf16*)(A->ws + WS_RTR) + (size_t)(l * 2 + 1) * 48 * 1024;
    unsigned* cnt = (unsigned*)(A->ws + WS_CTL) + CW_CNT + l * 32;
    unsigned* ltok = (unsigned*)(A->ws + WS_LTOK); float* lgate = (float*)(A->ws + WS_LGATE);
    LAS unsigned char* XH = F.lds; LAS unsigned char* XL = F.lds + 33024; LAS unsigned char* PS = F.lds + 66048;
    LAS float* LG = (LAS float*)(F.lds + 90624); LAS int* ASGE = (LAS int*)(F.lds + 93696); LAS float* ASGG = (LAS float*)(F.lds + 94720);
    LAS int* LCNT = (LAS int*)(F.lds + 95744); LAS int* LBASE = (LAS int*)(F.lds + 95872); LAS int* RANK = (LAS int*)(F.lds + 96000);
    const int lane = F.lane, wave = F.wave, tid = F.tid;
    bf16x8 BH[3][4], BL[3][4];
#pragma unroll
    for (int nt = 0; nt < 3; ++nt)
#pragma unroll
        for (int ksl = 0; ksl < 4; ++ksl) { const size_t off = (size_t)(16 * nt + (lane & 15)) * 1024 + 32 * (4 * wave + ksl) + 8 * (lane >> 4);
            BH[nt][ksl] = *(const GAS bf16x8*)(RH + off); BL[nt][ksl] = *(const GAS bf16x8*)(RL + off); }
    f32x4 gv[4], bv[4];
#pragma unroll
    for (int j = 0; j < 4; ++j) { gv[j] = *(const GAS f32x4*)(g + 4 * lane + 256 * j); bv[j] = *(const GAS f32x4*)(bb + 4 * lane + 256 * j); }
    for (int rb = F.bid; rb < T_TOK / 128; rb += F.G) {
        const int rowbase = rb * 128;
        if (tid < 32) LCNT[tid] = 0;
        for (int tt = 0; tt < 8; ++tt) {
#pragma unroll
            for (int rr = 0; rr < 2; ++rr) {
                const int rl = 2 * wave + rr; const size_t row = (size_t)(rowbase + 16 * tt + rl);
                f32x4 v[4]; float s = 0.f;
#pragma unroll
                for (int j = 0; j < 4; ++j) { v[j] = *(const GAS f32x4*)(R + row * DM + 4 * lane + 256 * j); s += (v[j].x + v[j].y) + (v[j].z + v[j].w); }
                const float mean = wave_sum(s) * (1.f / DM); float s2 = 0.f;
#pragma unroll
                for (int j = 0; j < 4; ++j) { v[j] = v[j] - mean; s2 += (v[j].x * v[j].x + v[j].y * v[j].y) + (v[j].z * v[j].z + v[j].w * v[j].w); }
                const float rstd = 1.f / sqrtf(wave_sum(s2) * (1.f / DM) + LN_EPS);
#pragma unroll
                for (int j = 0; j < 4; ++j) {
                    const f32x4 xn = v[j] * rstd * gv[j] + bv[j];
                    *(GAS f32x4*)(x + row * DM + 4 * lane + 256 * j) = xn;
                    const unsigned h0 = f2bf(xn.x), h1 = f2bf(xn.y), h2 = f2bf(xn.z), h3 = f2bf(xn.w);
                    v2u hw; hw.x = h0 | (h1 << 16); hw.y = h2 | (h3 << 16);
                    *(GAS v2u*)(XB + row * DM + 4 * lane + 256 * j) = hw;
                    v2u lw; lw.x = pk2(xn.x - __builtin_bit_cast(float, h0 << 16), xn.y - __builtin_bit_cast(float, h1 << 16)); lw.y = pk2(xn.z - __builtin_bit_cast(float, h2 << 16), xn.w - __builtin_bit_cast(float, h3 << 16));
                    *(LAS v2u*)(XH + rl * 2064 + (4 * lane + 256 * j) * 2) = hw; *(LAS v2u*)(XL + rl * 2064 + (4 * lane + 256 * j) * 2) = lw;
                }
            }
            __syncthreads();
            {
                f32x4 acc[3];
#pragma unroll
                for (int nt = 0; nt < 3; ++nt) acc[nt] = (f32x4){0.f, 0.f, 0.f, 0.f};
#pragma unroll
                for (int ksl = 0; ksl < 4; ++ksl) {
                    const int k0 = 32 * (4 * wave + ksl) + 8 * (lane >> 4);
                    const bf16x8 ah = *(const LAS bf16x8*)(XH + (lane & 15) * 2064 + k0 * 2), al = *(const LAS bf16x8*)(XL + (lane & 15) * 2064 + k0 * 2);
#pragma unroll
                    for (int nt = 0; nt < 3; ++nt) {
                        acc[nt] = __builtin_amdgcn_mfma_f32_16x16x32_bf16(ah, BH[nt][ksl], acc[nt], 0, 0, 0);
                        acc[nt] = __builtin_amdgcn_mfma_f32_16x16x32_bf16(ah, BL[nt][ksl], acc[nt], 0, 0, 0);
                        acc[nt] = __builtin_amdgcn_mfma_f32_16x16x32_bf16(al, BH[nt][ksl], acc[nt], 0, 0, 0);
                    }
                }
#pragma unroll
                for (int nt = 0; nt < 3; ++nt) *(LAS f32x4*)(PS + ((wave * 3 + nt) * 64 + lane) * 16) = acc[nt];
            }
            __syncthreads();
            if (tid < 192) {
                const int nt = tid >> 6, ln = tid & 63; f32x4 s = (f32x4){0.f, 0.f, 0.f, 0.f};
#pragma unroll
                for (int w = 0; w < 8; ++w) s += *(const LAS f32x4*)(PS + ((w * 3 + nt) * 64 + ln) * 16);
#pragma unroll
                for (int r = 0; r < 4; ++r) LG[(4 * (ln >> 4) + r) * 48 + 16 * nt + (ln & 15)] = s[r];
            }
            __syncthreads();
            if (tid < 16) {
                const LAS float* lg = LG + tid * 48;
                int gi = 0; float gm = lg[0];
#pragma unroll
                for (int j = 1; j < 4; ++j) { const float v = lg[j]; if (v > gm) { gm = v; gi = j; } }
                float gs = 0.f;
#pragma unroll
                for (int j = 0; j < 4; ++j) gs += __expf(lg[j] - gm);
                const float gp = 1.f / gs;
                float el[8];
#pragma unroll
                for (int j = 0; j < 8; ++j) el[j] = lg[4 + 8 * gi + j];
                int i1 = 0; float m1 = el[0];
#pragma unroll
                for (int j = 1; j < 8; ++j) if (el[j] > m1) { m1 = el[j]; i1 = j; }
                int i2 = -1; float m2 = -3.0e38f;
#pragma unroll
                for (int j = 0; j < 8; ++j) if (j != i1 && el[j] > m2) { m2 = el[j]; i2 = j; }
                const float e21 = __expf(m2 - m1); const float p1 = 1.f / (1.f + e21), p2 = e21 * p1;
                const int a0 = (16 * tt + tid) * 2;
                ASGE[a0] = 8 * gi + i1; ASGG[a0] = gp * p1; ASGE[a0 + 1] = 8 * gi + i2; ASGG[a0 + 1] = gp * p2;
            }
        }
        __syncthreads();
        if (tid < 256) RANK[tid] = __hip_atomic_fetch_add(&LCNT[ASGE[tid]], 1, __ATOMIC_RELAXED, __HIP_MEMORY_SCOPE_WORKGROUP);
        __syncthreads();
        if (tid < 32) LBASE[tid] = (int)__hip_atomic_fetch_add(cnt + tid, (unsigned)LCNT[tid], __ATOMIC_RELAXED, __HIP_MEMORY_SCOPE_AGENT);
        __syncthreads();
        if (tid < 256) { const int e = ASGE[tid]; const int slot = LBASE[e] + RANK[tid];
            ltok[(size_t)e * T_TOK + slot] = (unsigned)(rowbase + (tid >> 1)) | ((unsigned)(tid & 1) << 31); lgate[(size_t)e * T_TOK + slot] = ASGG[tid]; }
        __syncthreads();
    }
}

__device__ __forceinline__ void phase_ln2(ArgsCP A, Frame F, int l) {
    FRAME_REFRESH(F);
    float* x = A->out; bf16* XB = (bf16*)(A->ws + WS_XB); const bf16* YB = (const bf16*)(A->ws + WS_H);
    const float* g = A->ln2_g + l * DM; const float* bb = A->ln2_b + l * DM;
    const int lane = F.lane; const int gw = F.bid * 8 + F.wave, NGW = F.G * 8;
    f32x4 gv[4], bv[4];
#pragma unroll
    for (int j = 0; j < 4; ++j) { gv[j] = *(const GAS f32x4*)(g + 4 * lane + 256 * j); bv[j] = *(const GAS f32x4*)(bb + 4 * lane + 256 * j); }
    for (int m = gw; m < T_TOK; m += NGW) {
        const size_t row = (size_t)m;
        f32x4 v[4]; float s = 0.f;
#pragma unroll
        for (int j = 0; j < 4; ++j) {
            const f32x4 xv = *(const GAS f32x4*)(x + row * DM + 4 * lane + 256 * j);
            const v2u y0 = *(const GAS v2u*)(YB + row * DM + 4 * lane + 256 * j), y1 = *(const GAS v2u*)(YB + ((size_t)T_TOK + row) * DM + 4 * lane + 256 * j);
            v[j].x = xv.x * ALPHA + (bflo(y0.x) + bflo(y1.x)); v[j].y = xv.y * ALPHA + (bfhi(y0.x) + bfhi(y1.x));
            v[j].z = xv.z * ALPHA + (bflo(y0.y) + bflo(y1.y)); v[j].w = xv.w * ALPHA + (bfhi(y0.y) + bfhi(y1.y));
            s += (v[j].x + v[j].y) + (v[j].z + v[j].w);
        }
        const float mean = wave_sum(s) * (1.f / DM); float s2 = 0.f;
#pragma unroll
        for (int j = 0; j < 4; ++j) { v[j] = v[j] - mean; s2 += (v[j].x * v[j].x + v[j].y * v[j].y) + (v[j].z * v[j].z + v[j].w * v[j].w); }
        const float rstd = 1.f / sqrtf(wave_sum(s2) * (1.f / DM) + LN_EPS);
#pragma unroll
        for (int j = 0; j < 4; ++j) {
            const f32x4 xn = v[j] * rstd * gv[j] + bv[j];
            *(GAS f32x4*)(x + row * DM + 4 * lane + 256 * j) = xn;
            v2u hw; hw.x = pk2(xn.x, xn.y); hw.y = pk2(xn.z, xn.w);
            *(GAS v2u*)(XB + row * DM + 4 * lane + 256 * j) = hw;
        }
    }
}

__global__ void __launch_bounds__(512, 2) hybrid_fwd(Args A_unused) {
    extern __shared__ __attribute__((aligned(16))) unsigned char lds_raw[];
    Frame F;
    F.lds = (LAS unsigned char*)lds_raw;
    F.tid = threadIdx.x; F.lane = F.tid & 63; F.wave = __builtin_amdgcn_readfirstlane(F.tid >> 6); F.G = gridDim.x; F.bid = blockIdx.x;
    volatile LAS unsigned* MISC = (volatile LAS unsigned*)(F.lds + MISC_OFF);
    for (int u = F.tid; u < (LDS_BYTES - TAB_OFF) / 4; u += 512) ((LAS unsigned*)(F.lds + TAB_OFF))[u] = 0u;
    __syncthreads();
    XcdBarrier bar;
    { ArgsCP A = ARGS_PTR(); bar = xcd_barrier_post((unsigned*)(A->ws + WS_CTL) + CW_BAR, MISC + 8); }
    LAS unsigned* tab = (LAS unsigned*)(F.lds + TAB_OFF);
    LAS int* bst = (LAS int*)(F.lds + BST_OFF);

#if PH_P0
    phase_prologue(ARGS_PTR(), F);
#endif
    xcd_barrier(bar);

    for (int l = 0; l < NLAYER; ++l) {
        const int li = l >> 1;
        if ((l & 1) == 0) {
            {
                ArgsCP A = ARGS_PTR();
                pg8::Gemm g{(const bf16*)(A->ws + WS_XB), (const bf16*)(A->ws + WS_WIN) + (size_t)li * MIXIN * DM, 0, nullptr};
                pg8::StaticOrder S; S.init(T_TOK, MIXIN, F.G, F.bid);
                pg8::EpiH E{(bf16*)(A->ws + WS_H)};
#if PH_E1
                pg8::gemm_phase<pg8::EpiH, pg8::StaticOrder, false, DM>(F.lds, tab, g, S, E);
#endif
            }
            xcd_barrier(bar);
#if PH_E2
            phase_gmlp(ARGS_PTR(), F, li);
#endif
            xcd_barrier(bar);
            {
                ArgsCP A = ARGS_PTR();
                pg8::Gemm g{(const bf16*)(A->ws + WS_Y), (const bf16*)(A->ws + WS_WOUT) + (size_t)li * DM * DM, 0, nullptr};
                pg8::StaticOrder S; S.init(T_TOK, DM, F.G, F.bid);
                pg8::EpiRes E{(l == 0) ? A->x : (const float*)A->out, (float*)(A->ws + WS_H), nullptr};
#if PH_E3
                pg8::gemm_phase<pg8::EpiRes, pg8::StaticOrder, false, DM>(F.lds, tab, g, S, E);
#endif
            }
            xcd_barrier(bar);
        } else {
            {
                ArgsCP A = ARGS_PTR();
                pg8::Gemm g{(const bf16*)(A->ws + WS_XB), (const bf16*)(A->ws + WS_WQKV) + (size_t)li * QKVD * DM, 0, nullptr};
                pg8::StaticOrder S; S.init(T_TOK, QKVD, F.G, F.bid);
                pg8::EpiQKV E{(bf16*)(A->ws + WS_QB), (bf16*)(A->ws + WS_KB), (bf16*)(A->ws + WS_VT), A->attn_b_qkv + li * QKVD};
#if PH_A1
                pg8::gemm_phase<pg8::EpiQKV, pg8::StaticOrder, false, DM>(F.lds, tab, g, S, E);
#endif
            }
            xcd_barrier(bar);
#if PH_A2
            phase_attn(ARGS_PTR(), F, li);
#endif
            xcd_barrier(bar);
            {
                ArgsCP A = ARGS_PTR();
                pg8::Gemm g{(const bf16*)(A->ws + WS_Y), (const bf16*)(A->ws + WS_WO) + (size_t)li * DM * DM, 0, nullptr};
                pg8::StaticOrder S; S.init(T_TOK, DM, F.G, F.bid);
                pg8::EpiRes E{(const float*)A->out, (float*)(A->ws + WS_H), A->attn_b_o + li * DM};
#if PH_A3
                pg8::gemm_phase<pg8::EpiRes, pg8::StaticOrder, false, DM>(F.lds, tab, g, S, E);
#endif
            }
            xcd_barrier(bar);
        }
#if PH_L1
        phase_ln1(ARGS_PTR(), F, l);
#endif
        xcd_barrier(bar);
        {
            ArgsCP A = ARGS_PTR();
            unsigned* ctl = (unsigned*)(A->ws + WS_CTL);
            const int tid = threadIdx.x;
            if (tid < 32) { const int c = (int)__hip_atomic_load(ctl + CW_CNT + l * 32 + tid, __ATOMIC_RELAXED, __HIP_MEMORY_SCOPE_AGENT); bst[64 + tid] = c; bst[96 + tid] = (c + 255) >> 8; }
            __syncthreads();
            if (tid == 0) { int s = 0; for (int e = 0; e < 32; ++e) { bst[e] = s; s += bst[96 + e]; } bst[32] = s; }
            __syncthreads();
        }
        {
            ArgsCP A = ARGS_PTR();
            const int total = __builtin_amdgcn_readfirstlane(bst[32]);
            pg8::Gemm g{(const bf16*)(A->ws + WS_XB), (const bf16*)(A->ws + WS_W1) + (size_t)l * NEXP * DM * DM, (size_t)DM * DM * 2, (const unsigned*)(A->ws + WS_LTOK)};
            pg8::MoeOrder S{bst, total, F.G, F.bid};
            pg8::EpiHid E{(bf16*)(A->ws + WS_HID)};
#if PH_M1
            pg8::gemm_phase<pg8::EpiHid, pg8::MoeOrder, true, DM>(F.lds, tab, g, S, E);
#endif
        }
        xcd_barrier(bar);
        {
            ArgsCP A = ARGS_PTR();
            const int total = __builtin_amdgcn_readfirstlane(bst[32]);
            pg8::Gemm g{(const bf16*)(A->ws + WS_HID), (const bf16*)(A->ws + WS_W2) + (size_t)l * NEXP * DM * DEXP, (size_t)DM * DEXP * 2, nullptr};
            pg8::MoeOrder S{bst, total, F.G, F.bid};
            pg8::EpiScatter E{(bf16*)(A->ws + WS_H), (const unsigned*)(A->ws + WS_LTOK), (const float*)(A->ws + WS_LGATE)};
#if PH_M2
            pg8::gemm_phase<pg8::EpiScatter, pg8::MoeOrder, false, DEXP>(F.lds, tab, g, S, E);
#endif
        }
        xcd_barrier(bar);
#if PH_L2
        phase_ln2(ARGS_PTR(), F, l);
#endif
        if (l + 1 < NLAYER) xcd_barrier(bar);
    }
}

extern "C" void kernel_launch(void* const* d_in, const int* in_sizes, int n_in, void* d_out, int out_size, void* d_ws, size_t ws_size, hipStream_t stream) {
    static int grid = 0;
    if (grid == 0) {
        if (n_in != 23 || out_size != T_TOK * DM || ws_size < WS_END) { fprintf(stderr, "kernel_launch: unexpected shapes (n_in %d, out %d, ws %zu, need %zu)\n", n_in, out_size, ws_size, (size_t)WS_END); grid = -1; return; }
        int dev = 0, cus = 0, per_cu = 0;
        if (hipGetDevice(&dev) != hipSuccess || hipDeviceGetAttribute(&cus, hipDeviceAttributeMultiprocessorCount, dev) != hipSuccess) { grid = -1; return; }
        if (hipFuncSetAttribute((const void*)hybrid_fwd, hipFuncAttributeMaxDynamicSharedMemorySize, LDS_BYTES) != hipSuccess) { fprintf(stderr, "kernel_launch: hipFuncSetAttribute failed\n"); grid = -1; return; }
        if (hipOccupancyMaxActiveBlocksPerMultiprocessor(&per_cu, (const void*)hybrid_fwd, 512, LDS_BYTES) != hipSuccess || per_cu < 1) fprintf(stderr, "kernel_launch: occupancy query reports %d\n", per_cu);
        (void)hipGetLastError();
        grid = cus;
    }
    if (grid < 0) return;
    if (hipMemsetAsync((char*)d_ws + WS_CTL, 0, CTL_ZERO_BYTES, stream) != hipSuccess) return;
    Args a{};
    const float** p = (const float**)&a;
    for (int i = 0; i < 23; ++i) p[i] = (const float*)d_in[i];
    a.out = (float*)d_out; a.ws = (unsigned char*)d_ws;
    hipLaunchKernelGGL(hybrid_fwd, dim3(grid), dim3(512), LDS_BYTES, stream, a);
}
```

```cpp
#include <hip/hip_runtime.h>
#include <cstdio>
#include <cstdint>
#ifndef REP_P0
#define REP_P0 1
#endif
#ifndef REP_E1
#define REP_E1 1
#endif
#ifndef REP_E2
#define REP_E2 1
#endif
#ifndef REP_E3
#define REP_E3 1
#endif
#ifndef REP_A1
#define REP_A1 1
#endif
#ifndef REP_A2
#define REP_A2 1
#endif
#ifndef REP_A3
#define REP_A3 1
#endif
#ifndef REP_M1
#define REP_M1 1
#endif
#ifndef REP_M2
#define REP_M2 1
#endif
#ifndef PH_P0
#define PH_P0 1
#endif
#ifndef PH_E1
#define PH_E1 1
#endif
#ifndef PH_E2
#define PH_E2 1
#endif
#ifndef PH_E3
#define PH_E3 1
#endif
#ifndef PH_A1
#define PH_A1 1
#endif
#ifndef PH_A2
#define PH_A2 1
#endif
#ifndef PH_A3
#define PH_A3 1
#endif
#ifndef PH_L1
#define PH_L1 1
#endif
#ifndef PH_M1
#define PH_M1 1
#endif
#ifndef PH_M2
#define PH_M2 1
#endif
#ifndef PH_L2
#define PH_L2 1
#endif

constexpr int T_TOK = 32768, SEQ = 16384, DM = 1024, NLAYER = 4;
constexpr int MIXIN = 2560, QKVD = 1280, DEXP = 512, NEXP = 32;
constexpr float ALPHA = 1.681792830507429f;
constexpr float LN_EPS = 1e-5f;

namespace pg8 {
#define PG8_LAS __attribute__((address_space(3)))
typedef unsigned short bf16_t;
typedef short bf16x8 __attribute__((ext_vector_type(8)));
typedef float f32x4 __attribute__((ext_vector_type(4)));
typedef float f32x2 __attribute__((ext_vector_type(2)));
typedef unsigned u32x4 __attribute__((ext_vector_type(4)));
constexpr int BM = 256, BK = 64, HALF = 128, HTB = HALF * BK * 2  , STAGE_BYTES = 8 * HTB, NXCD = 8, WGM = 8;

__host__ __device__ __forceinline__ int lds_byte(int r, int c) { const int st = (r >> 4) * 2 + (c >> 5), rr = r & 15, cc = c & 31, ob = rr * 64 + cc * 2; return st * 1024 + (ob ^ (((ob >> 9) & 1) << 5)); }
__host__ __device__ __forceinline__ void stage_rc(int b, int& R, int& C) { const int st = b / 1024, sb = b % 1024, swz = sb ^ (((sb >> 9) & 1) << 5); R = (st >> 1) * 16 + swz / 64; C = (st & 1) * 32 + (swz % 64) / 2; }
__host__ __device__ __forceinline__ int perm32(int rho) { const int n = rho >> 4, i = rho & 15; return 8 * (i >> 2) + 4 * n + (i & 3); }

struct Unit { int pm, pn, e, lbase, rows; };
struct Gemm { const bf16_t* A; const bf16_t* Bt; size_t bstride; const unsigned* list; };

struct StaticOrder {
    int nM, nN, nwg, G, c;
    __device__ void init(int M, int N, int G_, int c_) { nM = M / BM; nN = N / BM; nwg = nM * nN; G = G_; c = c_; }
    __device__ bool next(int i, Unit& u) const {
        const long L = (long)i * G + c; if (L >= nwg) return false;
        int wgid = (int)L; { const int q = nwg / NXCD, r = nwg % NXCD, xcd = wgid % NXCD, off = wgid / NXCD; wgid = (xcd < r ? xcd * (q + 1) : r * (q + 1) + (xcd - r) * q) + off; }
        const int nig = WGM * nN, gid = wgid / nig, fm = gid * WGM, gsz = (nM - fm) < WGM ? (nM - fm) : WGM;
        u.pm = fm + ((wgid % nig) % gsz); u.pn = (wgid % nig) / gsz; u.e = 0; u.lbase = 0; u.rows = BM; return true;
    }
};
struct MoeOrder {
    const PG8_LAS int* bst; int total, G, c;
    __device__ bool next(int i, Unit& u) const {
        const int L = i * G + c; if (L >= total * 4) return false;
        const int blk = L >> 2; int e = 0;
#pragma unroll
        for (int k = 1; k < 32; ++k) e += (bst[k] <= blk) ? 1 : 0;
        e = __builtin_amdgcn_readfirstlane(e);
        const int rb = blk - __builtin_amdgcn_readfirstlane(bst[e]); const int cnt = __builtin_amdgcn_readfirstlane(bst[64 + e]);
        int rows = cnt - rb * BM; rows = rows > BM ? BM : rows;
        u.pm = blk; u.pn = L & 3; u.e = e; u.lbase = e * T_TOK + rb * BM; u.rows = rows; return true;
    }
};

__device__ __forceinline__ unsigned cvt_pk_bf16(float lo, float hi) { unsigned r; asm volatile("v_cvt_pk_bf16_f32 %0, %1, %2" : "=v"(r) : "v"(lo), "v"(hi)); return r; }
__device__ __forceinline__ f32x2 gelu_pk(f32x2 v) {
    const f32x2 av = __builtin_elementwise_abs(v), d = av * 0.2316418882f + 1.0f;
    f32x2 t; t.x = __builtin_amdgcn_rcpf(d.x); t.y = __builtin_amdgcn_rcpf(d.y);
    f32x2 q = t * 0.5307027145f + (-0.7265760135f); q = q * t + 0.7107068705f; q = q * t + (-0.142248368f); q = q * t + 0.127414796f; q = q * t;
    const f32x2 s = (v * v) * (-0.72134752044f);
    f32x2 e; e.x = __builtin_amdgcn_exp2f(s.x); e.y = __builtin_amdgcn_exp2f(s.y);
    const f32x2 m = v * (q * e), r = v - m;
    f32x2 o; o.x = v.x < 0.f ? m.x : r.x; o.y = v.y < 0.f ? m.y : r.y; return o;
}
__device__ __forceinline__ u32x4 pack8(f32x4 v0, f32x4 v1) { u32x4 w; w.x = cvt_pk_bf16(v0[0], v0[1]); w.y = cvt_pk_bf16(v0[2], v0[3]); w.z = cvt_pk_bf16(v1[0], v1[1]); w.w = cvt_pk_bf16(v1[2], v1[3]); return w; }

struct EpiH {
    static constexpr bool PERM = true;
    bf16_t* O;
    __device__ __forceinline__ void operator()(const f32x4 (&acc)[2][2][4][2], const Unit& u, int wr, int wc, int fr, int fq) const {
        const int row0 = u.pm * BM + wr * 64 + fr, col0 = u.pn * BM + wc * 32 + 8 * fq; const bool act = u.pn < 4;
#pragma unroll
        for (int ai = 0; ai < 2; ++ai)
#pragma unroll
            for (int m = 0; m < 4; ++m) { bf16_t* rowp = O + (size_t)(row0 + ai * HALF + m * 16) * MIXIN + col0;
#pragma unroll
                for (int bj = 0; bj < 2; ++bj) { f32x4 v0 = acc[ai][bj][m][0], v1 = acc[ai][bj][m][1];
                    if (act) { f32x2 a = gelu_pk((f32x2){v0[0], v0[1]}), b = gelu_pk((f32x2){v0[2], v0[3]}), c = gelu_pk((f32x2){v1[0], v1[1]}), d = gelu_pk((f32x2){v1[2], v1[3]});
                        v0 = (f32x4){a.x, a.y, b.x, b.y}; v1 = (f32x4){c.x, c.y, d.x, d.y}; }
                    *(u32x4*)(rowp + bj * HALF) = pack8(v0, v1); } }
    }
};
struct EpiQKV {
    static constexpr bool PERM = true;
    bf16_t* Q; bf16_t* Kb; bf16_t* Vt; const float* bias;
    __device__ __forceinline__ void operator()(const f32x4 (&acc)[2][2][4][2], const Unit& u, int wr, int wc, int fr, int fq) const {
        const int row0 = u.pm * BM + wr * 64 + fr, cw = wc * 32 + 8 * fq;
        f32x4 bv[2][2];
#pragma unroll
        for (int bj = 0; bj < 2; ++bj)
#pragma unroll
            for (int n = 0; n < 2; ++n) bv[bj][n] = *(const f32x4*)(bias + u.pn * BM + bj * HALF + cw + 4 * n);
        if (u.pn < 4) {
#pragma unroll
            for (int ai = 0; ai < 2; ++ai)
#pragma unroll
                for (int m = 0; m < 4; ++m) { bf16_t* rowp = Q + (size_t)(row0 + ai * HALF + m * 16) * DM + u.pn * BM + cw;
#pragma unroll
                    for (int bj = 0; bj < 2; ++bj) *(u32x4*)(rowp + bj * HALF) = pack8((acc[ai][bj][m][0] + bv[bj][0]) * 0.125f, (acc[ai][bj][m][1] + bv[bj][1]) * 0.125f); }
        } else {
#pragma unroll
            for (int ai = 0; ai < 2; ++ai)
#pragma unroll
                for (int m = 0; m < 4; ++m) { const int row = row0 + ai * HALF + m * 16;
                    *(u32x4*)(Kb + (size_t)row * 128 + cw) = pack8(acc[ai][0][m][0] + bv[0][0], acc[ai][0][m][1] + bv[0][1]);
                    bf16_t* vrow = Vt + ((size_t)((row >> 14) * 128 + cw)) * SEQ + (row & (SEQ - 1));
#pragma unroll
                    for (int n = 0; n < 2; ++n) { const f32x4 v = acc[ai][1][m][n] + bv[1][n];
#pragma unroll
                        for (int j = 0; j < 4; ++j) vrow[(size_t)(4 * n + j) * SEQ] = (bf16_t)(cvt_pk_bf16(v[j], 0.f) & 0xffffu); }
                    asm volatile("" ::: "memory"); }
        }
    }
};
struct EpiRes {
    static constexpr bool PERM = true;
    const bf16_t* xres; bf16_t* R; const float* bias;
    __device__ __forceinline__ void operator()(const f32x4 (&acc)[2][2][4][2], const Unit& u, int wr, int wc, int fr, int fq) const {
        const int row0 = u.pm * BM + wr * 64 + fr, col0 = u.pn * BM + wc * 32 + 8 * fq;
        f32x4 bv[2][2];
#pragma unroll
        for (int bj = 0; bj < 2; ++bj)
#pragma unroll
            for (int n = 0; n < 2; ++n) bv[bj][n] = bias ? *(const f32x4*)(bias + col0 + bj * HALF + 4 * n) : (f32x4){0.f, 0.f, 0.f, 0.f};
#pragma unroll
        for (int ai = 0; ai < 2; ++ai)
#pragma unroll
            for (int m = 0; m < 4; ++m) { const size_t off = (size_t)(row0 + ai * HALF + m * 16) * DM + col0;
#pragma unroll
                for (int bj = 0; bj < 2; ++bj) { const u32x4 xr = *(const u32x4*)(xres + off + bj * HALF);
                    f32x4 x0, x1;
                    x0[0] = __builtin_bit_cast(float, xr.x << 16); x0[1] = __builtin_bit_cast(float, xr.x & 0xffff0000u); x0[2] = __builtin_bit_cast(float, xr.y << 16); x0[3] = __builtin_bit_cast(float, xr.y & 0xffff0000u);
                    x1[0] = __builtin_bit_cast(float, xr.z << 16); x1[1] = __builtin_bit_cast(float, xr.z & 0xffff0000u); x1[2] = __builtin_bit_cast(float, xr.w << 16); x1[3] = __builtin_bit_cast(float, xr.w & 0xffff0000u);
                    *(u32x4*)(R + off + bj * HALF) = pack8(x0 * ALPHA + acc[ai][bj][m][0] + bv[bj][0], x1 * ALPHA + acc[ai][bj][m][1] + bv[bj][1]); }
                if (m & 1) asm volatile("" ::: "memory"); }
    }
};
struct EpiHid {
    static constexpr bool PERM = true;
    bf16_t* hid;
    __device__ __forceinline__ float silu(float g) const { return g * __builtin_amdgcn_rcpf(1.0f + __expf(-g)); }
    __device__ __forceinline__ void operator()(const f32x4 (&acc)[2][2][4][2], const Unit& u, int wr, int wc, int fr, int fq) const {
        const int row0 = u.pm * BM + wr * 64 + fr, col0 = u.pn * HALF + wc * 32 + 8 * fq;
#pragma unroll
        for (int ai = 0; ai < 2; ++ai)
#pragma unroll
            for (int m = 0; m < 4; ++m) { f32x4 h0, h1;
#pragma unroll
                for (int j = 0; j < 4; ++j) { h0[j] = silu(acc[ai][0][m][0][j]) * acc[ai][1][m][0][j]; h1[j] = silu(acc[ai][0][m][1][j]) * acc[ai][1][m][1][j]; }
                *(u32x4*)(hid + (size_t)(row0 + ai * HALF + m * 16) * DEXP + col0) = pack8(h0, h1); }
    }
};
struct EpiScatter {
    static constexpr bool PERM = true;
    bf16_t* yb; const unsigned* ltok; const float* lgate;
    __device__ __forceinline__ void operator()(const f32x4 (&acc)[2][2][4][2], const Unit& u, int wr, int wc, int fr, int fq) const {
        const int col0 = u.pn * BM + wc * 32 + 8 * fq;
#pragma unroll
        for (int ai = 0; ai < 2; ++ai)
#pragma unroll
            for (int m = 0; m < 4; ++m) { const int r = ai * HALF + wr * 64 + m * 16 + fr;
                if (r < u.rows) { const unsigned ent = ltok[u.lbase + r]; const float gt = lgate[u.lbase + r];
                    bf16_t* dst = yb + ((size_t)(ent >> 31) * T_TOK + (ent & 0x7fffffffu)) * DM + col0;
#pragma unroll
                    for (int bj = 0; bj < 2; ++bj) *(u32x4*)(dst + bj * HALF) = pack8(acc[ai][bj][m][0] * gt, acc[ai][bj][m][1] * gt); } }
    }
};

__device__ __forceinline__ void gather_offs(const PG8_LAS unsigned* tab, int rows, const int (&Rr)[2], const unsigned (&cb)[2], unsigned rowbytes, unsigned (&v0)[2], unsigned (&v1)[2]) {
#pragma unroll
    for (int i = 0; i < 2; ++i) { unsigned t0 = tab[Rr[i]] & 0x7fffffffu, t1 = tab[HALF + Rr[i]] & 0x7fffffffu;
        t0 = Rr[i] < rows ? t0 : 0u; t1 = (HALF + Rr[i]) < rows ? t1 : 0u;
        v0[i] = t0 * rowbytes + cb[i]; v1[i] = t1 * rowbytes + cb[i]; }
}

template <class Epi, class Sched, bool GATHER, int K>
__device__ __forceinline__ void gemm_phase(PG8_LAS unsigned char* lds, PG8_LAS unsigned* tab, const Gemm g, const Sched& S, const Epi& E) {
    int tid_ = threadIdx.x; asm volatile("" : "+v"(tid_));
    const int tid = tid_, wid = __builtin_amdgcn_readfirstlane(tid >> 6), lane = tid & 63, wr = wid >> 2, wc = wid & 3, fr = lane & 15, fq = lane >> 4;
    constexpr int nt = K / BK;
    int Rr[2]; unsigned cb[2], voffB[2], vC0[2], vC1[2], vN0[2], vN1[2];
#pragma unroll
    for (int i = 0; i < 2; ++i) { int R, C; stage_rc(tid * 16 + i * 8192, R, C); const int Rb = Epi::PERM ? ((R & ~31) + perm32(R & 31)) : R;
        Rr[i] = R; cb[i] = (unsigned)C * 2u; voffB[i] = (unsigned)(Rb * K + C) * 2u;
        vC0[i] = (unsigned)(R * K + C) * 2u; vC1[i] = (unsigned)((R + HALF) * K + C) * 2u; vN0[i] = vC0[i]; vN1[i] = vC1[i]; }
    constexpr size_t kstep = (size_t)(BK * 2);
    constexpr size_t hstep = (size_t)HALF * K * 2;
    constexpr size_t tstep = 2 * hstep;
    const unsigned ldsw = (unsigned)wid * 1024u;
    const int aoff = lds_byte(wr * 64 + fr, fq * 8), boff = lds_byte(wc * 32 + fr, fq * 8);
#define PG8_SA(b, h) (((b) * 2 + (h)) * HTB)
#define PG8_SB(b, h) ((4 + (b) * 2 + (h)) * HTB)
#define PG8_STAGE(bufoff, gbase, voff) do { _Pragma("unroll") for (int _i = 0; _i < 2; ++_i) \
        __builtin_amdgcn_global_load_lds((const unsigned*)((const char*)(gbase) + (voff)[_i]), (PG8_LAS unsigned*)(lds + (bufoff) + ldsw + _i * 8192), 16, 0, 0); } while (0)
#define PG8_LDA(dst, b, h) do { _Pragma("unroll") for (int m = 0; m < 4; ++m) _Pragma("unroll") for (int k = 0; k < 2; ++k) dst[m][k] = *(const PG8_LAS bf16x8*)(lds + PG8_SA(b, h) + aoff + m * 2048 + k * 1024); } while (0)
#define PG8_LDB(dst, b, h) do { _Pragma("unroll") for (int n = 0; n < 2; ++n) _Pragma("unroll") for (int k = 0; k < 2; ++k) dst[n][k] = *(const PG8_LAS bf16x8*)(lds + PG8_SB(b, h) + boff + n * 2048 + k * 1024); } while (0)
#define PG8_MMA(ai, bj, At, Bt) do { __builtin_amdgcn_s_setprio(1); _Pragma("unroll") for (int m = 0; m < 4; ++m) _Pragma("unroll") for (int n = 0; n < 2; ++n) _Pragma("unroll") for (int k = 0; k < 2; ++k) \
        acc[ai][bj][m][n] = __builtin_amdgcn_mfma_f32_16x16x32_bf16(Bt[n][k], At[m][k], acc[ai][bj][m][n], 0, 0, 0); __builtin_amdgcn_s_setprio(0); } while (0)
#define PG8_WAIT_V(n) asm volatile("s_waitcnt vmcnt(" #n ")" ::: "memory")
#define PG8_WAIT_L(n) asm volatile("s_waitcnt lgkmcnt(" #n ")" ::: "memory")
#define PG8_BAR __builtin_amdgcn_s_barrier()
#define PG8_SCHED __builtin_amdgcn_sched_barrier(0)
    Unit cur, nxt; int ui = 0;
    if (!S.next(0, cur)) return;
    f32x4 acc[2][2][4][2];
#pragma unroll
    for (int a = 0; a < 2; ++a)
#pragma unroll
        for (int b = 0; b < 2; ++b)
#pragma unroll
            for (int m = 0; m < 4; ++m)
#pragma unroll
                for (int n = 0; n < 2; ++n) acc[a][b][m][n] = (f32x4){0.f, 0.f, 0.f, 0.f};
    bf16x8 At[4][2], B0[2][2], B1[2][2];
    if constexpr (GATHER) {
        if (wid == 0) { __builtin_amdgcn_global_load_lds(g.list + cur.lbase + lane * 4, tab, 16, 0, 0); asm volatile("s_waitcnt vmcnt(0)" ::: "memory"); }
        __syncthreads();
        gather_offs(tab, cur.rows, Rr, cb, (unsigned)(K * 2), vC0, vC1);
    }
    const char* cA = GATHER ? (const char*)g.A : (const char*)g.A + (size_t)cur.pm * tstep;
    const char* cB = (const char*)g.Bt + (size_t)cur.e * g.bstride + (size_t)cur.pn * tstep;
    PG8_STAGE(PG8_SB(0, 0), cB, voffB); PG8_STAGE(PG8_SB(0, 1), cB + hstep, voffB); PG8_STAGE(PG8_SA(0, 0), cA, vC0); PG8_STAGE(PG8_SA(0, 1), cA, vC1);
    if (wr == 1) PG8_BAR;
    PG8_WAIT_V(2); PG8_BAR;
    PG8_STAGE(PG8_SB(1, 0), cB + kstep, voffB); PG8_STAGE(PG8_SA(1, 0), cA + kstep, vC0); PG8_STAGE(PG8_SB(1, 1), cB + hstep + kstep, voffB);
    PG8_WAIT_V(6); PG8_BAR;
    for (;;) {
        const bool has_next = S.next(ui + 1, nxt);
        if constexpr (GATHER) { if (has_next && wid == 0) __builtin_amdgcn_global_load_lds(g.list + nxt.lbase + lane * 4, tab + ((ui + 1) & 1) * 256, 16, 0, 0); }
        const char* nA = GATHER ? (const char*)g.A : (has_next ? (const char*)g.A + (size_t)nxt.pm * tstep : cA);
        const char* nB = has_next ? (const char*)g.Bt + (size_t)nxt.e * g.bstride + (size_t)nxt.pn * tstep : cB;
        for (int t = 0; t < nt; t += 2) {
            const bool last = (t == nt - 2);
            if constexpr (GATHER) { if (last && has_next) gather_offs(tab + ((ui + 1) & 1) * 256, nxt.rows, Rr, cb, (unsigned)(K * 2), vN0, vN1); }
            unsigned w0[2], w1[2];
#pragma unroll
            for (int i = 0; i < 2; ++i) { w0[i] = last ? vN0[i] : vC0[i]; w1[i] = last ? vN1[i] : vC1[i]; }
            const char* a1 = cA + (size_t)(t + 1) * kstep;
            const char* a2 = last ? nA : cA + (size_t)(t + 2) * kstep; const char* b2 = last ? nB : cB + (size_t)(t + 2) * kstep;
            const char* a3 = a2 + kstep; const char* b3 = b2 + kstep;
            PG8_LDB(B0, 0, 0); PG8_LDB(B1, 0, 1); PG8_SCHED; PG8_LDA(At, 0, 0); PG8_STAGE(PG8_SA(1, 1), a1, vC1);
            PG8_WAIT_V(8); PG8_WAIT_L(0); PG8_BAR; PG8_MMA(0, 0, At, B0); PG8_MMA(0, 1, At, B1); PG8_BAR; PG8_SCHED;
            PG8_LDA(At, 0, 1); PG8_STAGE(PG8_SB(0, 0), b2, voffB); PG8_STAGE(PG8_SB(0, 1), b2 + hstep, voffB); PG8_STAGE(PG8_SA(0, 0), a2, w0);
            PG8_WAIT_V(8); PG8_WAIT_L(0); PG8_BAR; PG8_MMA(1, 0, At, B0); PG8_MMA(1, 1, At, B1); PG8_BAR; PG8_SCHED;
            PG8_LDB(B0, 1, 0); PG8_LDB(B1, 1, 1); PG8_SCHED; PG8_LDA(At, 1, 0); PG8_STAGE(PG8_SA(0, 1), a2, w1);
            PG8_WAIT_V(8); PG8_WAIT_L(0); PG8_BAR; PG8_MMA(0, 0, At, B0); PG8_MMA(0, 1, At, B1); PG8_BAR; PG8_SCHED;
            PG8_LDA(At, 1, 1); PG8_STAGE(PG8_SB(1, 0), b3, voffB); PG8_STAGE(PG8_SB(1, 1), b3 + hstep, voffB); PG8_STAGE(PG8_SA(1, 0), a3, w0);
            PG8_WAIT_V(8); PG8_WAIT_L(0); PG8_BAR; PG8_MMA(1, 0, At, B0); PG8_MMA(1, 1, At, B1); PG8_BAR; PG8_SCHED;
        }
        if (wr == 0) PG8_BAR;
        E(acc, cur, wr, wc, fr, fq);
        if (!has_next) break;
#pragma unroll
        for (int a = 0; a < 2; ++a)
#pragma unroll
            for (int b = 0; b < 2; ++b)
#pragma unroll
                for (int m = 0; m < 4; ++m)
#pragma unroll
                    for (int n = 0; n < 2; ++n) acc[a][b][m][n] = (f32x4){0.f, 0.f, 0.f, 0.f};
        cur = nxt; cA = nA; cB = nB; ++ui;
#pragma unroll
        for (int i = 0; i < 2; ++i) { vC0[i] = vN0[i]; vC1[i] = vN1[i]; }
        if (wr == 1) PG8_BAR;
    }
    PG8_WAIT_V(0);
    PG8_BAR;
#undef PG8_SA
#undef PG8_SB
#undef PG8_STAGE
#undef PG8_LDA
#undef PG8_LDB
#undef PG8_MMA
#undef PG8_WAIT_V
#undef PG8_WAIT_L
#undef PG8_BAR
#undef PG8_SCHED
}
}

constexpr size_t MiB = 1u << 20;
constexpr size_t WS_CTL = 0, CTL_ZERO_BYTES = 1 * MiB;
constexpr size_t WS_WIN = 1 * MiB;
constexpr size_t WS_WOUT = WS_WIN + 10 * MiB;
constexpr size_t WS_WQKV = WS_WOUT + 4 * MiB;
constexpr size_t WS_WO = WS_WQKV + 5 * MiB;
constexpr size_t WS_RTR = WS_WO + 4 * MiB;
constexpr size_t WS_LTOK = WS_RTR + 1 * MiB;
constexpr size_t WS_LGATE = WS_LTOK + 4 * MiB;
constexpr size_t WS_W1 = WS_LGATE + 4 * MiB;
constexpr size_t WS_W2 = WS_W1 + 256 * MiB;
constexpr size_t WS_XB = WS_W2 + 128 * MiB;
constexpr size_t WS_H = WS_XB + 64 * MiB;
constexpr size_t WS_Y = WS_H + 160 * MiB;
constexpr size_t WS_HID = WS_Y + 64 * MiB;
constexpr size_t WS_END = WS_HID + 72 * MiB;
constexpr size_t WS_QB = WS_H, WS_KB = WS_H + 64 * MiB, WS_VT = WS_KB + 8 * MiB;
constexpr int CW_TMO = 0;
constexpr int CW_BAR = 4096;
constexpr int CW_CNT = 8192;
static_assert((CW_CNT + 128) * 4 <= (int)CTL_ZERO_BYTES, "ctl");

constexpr int RING_BYTES = 131072;
constexpr int TAB_OFF = RING_BYTES;
constexpr int BST_OFF = TAB_OFF + 2048;
constexpr int MISC_OFF = BST_OFF + 512;
constexpr int LDS_BYTES = 147456;
static_assert(MISC_OFF + 128 <= LDS_BYTES, "LDS map");

#define GAS __attribute__((address_space(1)))
#define LAS __attribute__((address_space(3)))
typedef unsigned short bf16;
typedef unsigned v4u __attribute__((ext_vector_type(4)));
typedef unsigned v2u __attribute__((ext_vector_type(2)));
typedef float f32x4 __attribute__((ext_vector_type(4)));
typedef float f32x16 __attribute__((ext_vector_type(16)));
typedef short bf16x8 __attribute__((ext_vector_type(8)));
#define LDS_WAIT() asm volatile("s_waitcnt lgkmcnt(0)" ::: "memory")
__device__ __forceinline__ unsigned f2bf(float f) { unsigned u = __builtin_bit_cast(unsigned, f); return (u + 0x7fffu + ((u >> 16) & 1u)) >> 16; }
__device__ __forceinline__ unsigned pk2(float lo, float hi) { return f2bf(lo) | (f2bf(hi) << 16); }
__device__ __forceinline__ float bflo(unsigned w) { return __builtin_bit_cast(float, w << 16); }
__device__ __forceinline__ float bfhi(unsigned w) { return __builtin_bit_cast(float, w & 0xffff0000u); }

#define XB_TMO      128
#define XB_XCNT(j)  (256  + 64 * (j))
#define XB_XSUB(j)  (1280 + 64 * (j))
#define XB_XGEN(j)  (2304 + 64 * (j))
#define XB_TOP      3328
#define XB_TOPGEN   3392
#define XCD_BAR_WORDS 3456
#define XB_SPIN_CAP (1u << 18)

__device__ __forceinline__ unsigned xb_ld(unsigned* p)              { return __hip_atomic_load(p, __ATOMIC_RELAXED, __HIP_MEMORY_SCOPE_AGENT); }
__device__ __forceinline__ unsigned xb_add(unsigned* p, unsigned v) { return __hip_atomic_fetch_add(p, v, __ATOMIC_RELAXED, __HIP_MEMORY_SCOPE_AGENT); }
__device__ __forceinline__ unsigned xb_xcc_id() { return (unsigned)__builtin_amdgcn_s_getreg((3 << 11) | 20) & 0xFu; }
#define XB_SPIN(cond, bar) do { unsigned _sp = 0; while (cond) { __builtin_amdgcn_s_sleep(1); \
    if ((++_sp & 255u) == 0u) { if (xb_ld(&(bar)[XB_TMO])) break; if (_sp > XB_SPIN_CAP) { atomicAdd(&(bar)[XB_TMO], 1u); break; } } } } while (0)

struct XcdBarrier {
    unsigned* bar; unsigned x;
    volatile LAS unsigned* st;
};
__device__ __forceinline__ XcdBarrier xcd_barrier_post(unsigned* bar, volatile LAS unsigned* st) {
    XcdBarrier b; b.bar = bar; b.x = xb_xcc_id(); b.st = st;
    if (threadIdx.x == 0) (void)xb_add(&bar[XB_XCNT(b.x)], 1u);
    return b;
}
__device__ __forceinline__ void xcd_barrier_complete(unsigned* bar, unsigned x, unsigned& nloc, unsigned& nx) {
    const unsigned G = gridDim.x * gridDim.y * gridDim.z;
    unsigned sum, cnt, mine, sp = 0u;
    for (;;) {
        sum = 0u; cnt = 0u; mine = 0u;
#pragma unroll
        for (unsigned j = 0; j < 16; ++j) { const unsigned c = xb_ld(&bar[XB_XCNT(j)]); sum += c; cnt += (c > 0u) ? 1u : 0u; mine = (j == x) ? c : mine; }
        if (sum == G) break;
        __builtin_amdgcn_s_sleep(1);
        if ((++sp & 255u) == 0u) { if (xb_ld(&bar[XB_TMO])) break; if (sp > XB_SPIN_CAP) { atomicAdd(&bar[XB_TMO], 1u); break; } }
    }
    nloc = mine > 0u ? mine : 1u; nx = cnt > 0u ? cnt : 1u;
}
__device__ __forceinline__ void xcd_barrier(const XcdBarrier& b) {
    asm volatile("s_waitcnt vmcnt(0)" ::: "memory");
    __syncthreads();
    if (threadIdx.x == 0) {
        unsigned* bar = b.bar;
        __builtin_amdgcn_s_waitcnt(0);
        unsigned nloc = b.st[0], nx = b.st[1];
        if (nloc == 0u) { xcd_barrier_complete(bar, b.x, nloc, nx); b.st[0] = nloc; b.st[1] = nx; }
        const unsigned old = xb_add(&bar[XB_XSUB(b.x)], 1u);
        const unsigned gen = old / nloc;
        if (old + 1u == (gen + 1u) * nloc) {
            __builtin_amdgcn_fence(__ATOMIC_RELEASE, "agent");
            asm volatile("s_waitcnt vmcnt(0)" ::: "memory");
            const unsigned og = xb_add(&bar[XB_TOP], 1u);
            const unsigned tg = og / nx;
            if (og + 1u == (tg + 1u) * nx) xb_add(&bar[XB_TOPGEN], 1u);
            else XB_SPIN(xb_ld(&bar[XB_TOPGEN]) == tg, bar);
            __builtin_amdgcn_fence(__ATOMIC_ACQUIRE, "agent");
            xb_add(&bar[XB_XGEN(b.x)], 1u);
            asm volatile("s_waitcnt vmcnt(0)" ::: "memory");
        } else {
            XB_SPIN(xb_ld(&bar[XB_XGEN(b.x)]) == gen, bar);
            __builtin_amdgcn_fence(__ATOMIC_ACQUIRE, "agent");
            asm volatile("s_waitcnt vmcnt(0)" ::: "memory");
        }
    }
    __syncthreads();
}

struct Args {
    const float* x; const float* rel_table; const float* mix_w_in; const float* gmlp_ln_g; const float* gmlp_ln_b; const float* gmlp_w_sp; const float* gmlp_b_sp;
    const float* conv_w; const float* mix_w_out; const float* attn_w_qkv; const float* attn_b_qkv; const float* attn_sinks; const float* attn_w_o; const float* attn_b_o;
    const float* ln1_g; const float* ln1_b; const float* ln2_g; const float* ln2_b; const float* router_group; const float* router_expert;
    const float* w_gate; const float* w_up; const float* w_down;
    float* out; unsigned char* ws;
};

typedef const __attribute__((address_space(4))) Args* ArgsCP;
#define ARGS_PTR() ({ ArgsCP p_ = (ArgsCP)__builtin_amdgcn_kernarg_segment_ptr(); asm volatile("" : "+s"(p_)); p_; })
struct Frame {
    LAS unsigned char* lds;
    int tid, lane, wave, G, bid;
};
#define FRAME_REFRESH(F) do { int t_ = threadIdx.x; asm volatile("" : "+v"(t_)); (F).tid = t_; (F).lane = t_ & 63; (F).wave = __builtin_amdgcn_readfirstlane(t_ >> 6); } while (0)

__device__ __forceinline__ float wave_sum(float v) {
#pragma unroll
    for (int o = 1; o < 64; o <<= 1) v += __shfl_xor(v, o);
    return v;
}

__device__ const unsigned char T5_BUCKET[128] = {0, 1, 2, 3, 4, 5, 6, 7, 8, 9, 10, 11, 12, 13, 14, 15, 16, 16, 16, 17, 17, 18, 18, 18, 19, 19, 19, 20, 20, 20, 20, 21, 21, 21, 21, 22, 22, 22, 22, 22, 23, 23, 23, 23, 23, 23, 24, 24, 24, 24, 24, 24, 25, 25, 25, 25, 25, 25, 25, 26, 26, 26, 26, 26, 26, 26, 26, 27, 27, 27, 27, 27, 27, 27, 27, 27, 27, 28, 28, 28, 28, 28, 28, 28, 28, 28, 28, 29, 29, 29, 29, 29, 29, 29, 29, 29, 29, 29, 29, 30, 30, 30, 30, 30, 30, 30, 30, 30, 30, 30, 30, 30, 30, 31, 31, 31, 31, 31, 31, 31, 31, 31, 31, 31, 31, 31, 31, 31};

__device__ __forceinline__ void p0_item(const float* W, int N, bf16* WT, int dstK, int dst_row0, LAS float* scr, int kb, int nb, int lane) {
    const int k0 = 64 * kb, n0 = 32 * nb;
#pragma unroll 8
    for (int i = 0; i < 32; ++i) { const int kk = 2 * i + (lane >> 5); scr[kk * 33 + (lane & 31)] = W[(size_t)(k0 + kk) * N + n0 + (lane & 31)]; }
    LDS_WAIT(); asm volatile("" ::: "memory");
    const int c = lane & 7;
#pragma unroll
    for (int j = 0; j < 4; ++j) { const int n = (lane >> 3) + 8 * j; const LAS float* s = scr + (8 * c) * 33 + n;
        v4u o; o.x = pk2(s[0 * 33], s[1 * 33]); o.y = pk2(s[2 * 33], s[3 * 33]); o.z = pk2(s[4 * 33], s[5 * 33]); o.w = pk2(s[6 * 33], s[7 * 33]);
        *(GAS v4u*)(WT + (size_t)(dst_row0 + n) * dstK + k0 + 8 * c) = o; }
    LDS_WAIT(); asm volatile("" ::: "memory");
}
__device__ __forceinline__ void phase_prologue(ArgsCP A, Frame F) {
    FRAME_REFRESH(F);
    LAS float* scr = (LAS float*)(F.lds + F.wave * 16384);
    const int gw = F.bid * 8 + F.wave, NGW = F.G * 8;
    constexpr int I_IN = 16 * 80, I_OUT = 16 * 32, I_QKV = 16 * 40, I_O = 16 * 32, I_SMALL = 2 * (I_IN + I_OUT + I_QKV + I_O), I_EXP = NLAYER * NEXP * 768;
    bf16* WIN = (bf16*)(A->ws + WS_WIN); bf16* WOUT = (bf16*)(A->ws + WS_WOUT); bf16* WQKV = (bf16*)(A->ws + WS_WQKV); bf16* WO = (bf16*)(A->ws + WS_WO);
    bf16* W1 = (bf16*)(A->ws + WS_W1); bf16* W2 = (bf16*)(A->ws + WS_W2);
    for (int it = gw; it < I_SMALL + I_EXP; it += NGW) {
        if (it < I_SMALL) {
            int r = it; const int i = r / (I_SMALL / 2); r -= i * (I_SMALL / 2);
            if (r < I_IN) { const int nbk = 80; p0_item(A->mix_w_in + (size_t)i * DM * MIXIN, MIXIN, WIN + (size_t)i * MIXIN * DM, DM, 32 * (r % nbk), scr, r / nbk, r % nbk, F.lane); continue; } r -= I_IN;
            if (r < I_OUT) { const int nbk = 32; p0_item(A->mix_w_out + (size_t)i * DM * DM, DM, WOUT + (size_t)i * DM * DM, DM, 32 * (r % nbk), scr, r / nbk, r % nbk, F.lane); continue; } r -= I_OUT;
            if (r < I_QKV) { const int nbk = 40; p0_item(A->attn_w_qkv + (size_t)i * DM * QKVD, QKVD, WQKV + (size_t)i * QKVD * DM, DM, 32 * (r % nbk), scr, r / nbk, r % nbk, F.lane); continue; } r -= I_QKV;
            { const int nbk = 32; p0_item(A->attn_w_o + (size_t)i * DM * DM, DM, WO + (size_t)i * DM * DM, DM, 32 * (r % nbk), scr, r / nbk, r % nbk, F.lane); }
        } else {
            const int r = it - I_SMALL, le = r / 768, q = r % 768, ty = q >> 8, item = q & 255;
            if (ty < 2) {
                const int kb = item >> 4, nb = item & 15, n0 = 32 * nb;
                p0_item((ty == 0 ? A->w_gate : A->w_up) + (size_t)le * DM * DEXP, DEXP, W1 + (size_t)le * DM * DM, DM, 256 * (n0 >> 7) + (n0 & 127) + 128 * ty, scr, kb, nb, F.lane);
            } else {
                const int kb = item >> 5, nb = item & 31;
                p0_item(A->w_down + (size_t)le * DEXP * DM, DM, W2 + (size_t)le * DM * DEXP, DEXP, 32 * nb, scr, kb, nb, F.lane);
            }
        }
    }
    bf16* XB = (bf16*)(A->ws + WS_XB);
    for (int m = gw; m < T_TOK; m += NGW) {
        const GAS f32x4* xr = (const GAS f32x4*)(A->x + (size_t)m * DM) + F.lane; GAS v2u* o = (GAS v2u*)(XB + (size_t)m * DM) + F.lane;
#pragma unroll
        for (int j = 0; j < 4; ++j) { const f32x4 v = xr[64 * j]; v2u w; w.x = pk2(v.x, v.y); w.y = pk2(v.z, v.w); o[64 * j] = w; }
    }
    bf16* RTR = (bf16*)(A->ws + WS_RTR);
    for (int idx = F.bid * 512 + F.tid; idx < NLAYER * 48 * 1024; idx += F.G * 512) {
        const int k = idx & 1023, n = (idx >> 10) % 48, l = idx / (48 * 1024);
        float w = 0.f;
        if (n < 4) w = A->router_group[((size_t)l * DM + k) * 4 + n]; else if (n < 36) w = A->router_expert[((size_t)l * DM + k) * 32 + (n - 4)];
        const unsigned hi = f2bf(w); const unsigned lo = f2bf(w - __builtin_bit_cast(float, hi << 16));
        RTR[((size_t)(l * 2 + 0) * 48 + n) * 1024 + k] = (bf16)hi; RTR[((size_t)(l * 2 + 1) * 48 + n) * 1024 + k] = (bf16)lo;
    }
}

__device__ __forceinline__ void phase_gmlp(ArgsCP A, Frame F, int li) {
    FRAME_REFRESH(F);
    const bf16* H = (const bf16*)(A->ws + WS_H); bf16* Y = (bf16*)(A->ws + WS_Y);
    const float* lng = A->gmlp_ln_g + li * 512; const float* lnb = A->gmlp_ln_b + li * 512;
    const float* wsp = A->gmlp_w_sp + (size_t)li * 4 * 128 * 128; const float* bsp = A->gmlp_b_sp + li * 4 * 128; const float* cw = A->conv_w + li * 3 * 512;
    LAS float* stat = (LAS float*)(F.lds);
    LAS unsigned char* VnT = F.lds + 1024;
    LAS unsigned char* WsL = F.lds + 1024 + 34816;
    const int lane = F.lane, wave = F.wave, tid = F.tid;
    for (int ch = F.bid; ch < T_TOK / 128; ch += F.G) {
        const int t0 = ch * 128;
        for (int rr = 0; rr < 16; ++rr) {
            const int rl = 16 * wave + rr;
            const v4u pk = *(const GAS v4u*)(H + (size_t)(t0 + rl) * MIXIN + 512 + lane * 8);
            float v[8] = {bflo(pk.x), bfhi(pk.x), bflo(pk.y), bfhi(pk.y), bflo(pk.z), bfhi(pk.z), bflo(pk.w), bfhi(pk.w)};
            float s = 0.f;
#pragma unroll
            for (int e = 0; e < 8; ++e) s += v[e];
            const float mean = wave_sum(s) * (1.f / 512.f); float q = 0.f;
#pragma unroll
            for (int e = 0; e < 8; ++e) { const float d = v[e] - mean; q += d * d; }
            const float rstd = 1.f / sqrtf(wave_sum(q) * (1.f / 512.f) + LN_EPS);
            if (lane == 0) { stat[2 * rl] = mean; stat[2 * rl + 1] = rstd; }
        }
        {
            const int c0 = 8 * lane, rstart = t0 + 16 * wave;
            float w0[8], w1[8], w2[8], z1[8], z2[8];
#pragma unroll
            for (int e = 0; e < 8; ++e) { w0[e] = cw[c0 + e]; w1[e] = cw[512 + c0 + e]; w2[e] = cw[1024 + c0 + e]; z1[e] = 0.f; z2[e] = 0.f; }
            if ((rstart & (SEQ - 1)) != 0) {
#pragma unroll
                for (int dr = 2; dr >= 1; --dr) {
                    const bf16* hr = H + (size_t)(rstart - dr) * MIXIN;
                    const v4u gc = *(const GAS v4u*)(hr + 1536 + c0), hb = *(const GAS v4u*)(hr + 2048 + c0);
                    float z[8] = {bflo(gc.x) * bflo(hb.x), bfhi(gc.x) * bfhi(hb.x), bflo(gc.y) * bflo(hb.y), bfhi(gc.y) * bfhi(hb.y), bflo(gc.z) * bflo(hb.z), bfhi(gc.z) * bfhi(hb.z), bflo(gc.w) * bflo(hb.w), bfhi(gc.w) * bfhi(hb.w)};
#pragma unroll
                    for (int e = 0; e < 8; ++e) { if (dr == 2) z2[e] = z[e]; else z1[e] = z[e]; }
                }
            }
            for (int dr = 0; dr < 16; ++dr) {
                const bf16* hr = H + (size_t)(rstart + dr) * MIXIN;
                const v4u gb = *(const GAS v4u*)(hr + 1024 + c0), gc = *(const GAS v4u*)(hr + 1536 + c0), hb = *(const GAS v4u*)(hr + 2048 + c0);
                float z[8] = {bflo(gc.x) * bflo(hb.x), bfhi(gc.x) * bfhi(hb.x), bflo(gc.y) * bflo(hb.y), bfhi(gc.y) * bfhi(hb.y), bflo(gc.z) * bflo(hb.z), bfhi(gc.z) * bfhi(hb.z), bflo(gc.w) * bflo(hb.w), bfhi(gc.w) * bfhi(hb.w)};
                float g[8] = {bflo(gb.x), bfhi(gb.x), bflo(gb.y), bfhi(gb.y), bflo(gb.z), bfhi(gb.z), bflo(gb.w), bfhi(gb.w)};
                float y[8];
#pragma unroll
                for (int e = 0; e < 8; ++e) { y[e] = g[e] * (w0[e] * z2[e] + w1[e] * z1[e] + w2[e] * z[e]); z2[e] = z1[e]; z1[e] = z[e]; }
                v4u o; o.x = pk2(y[0], y[1]); o.y = pk2(y[2], y[3]); o.z = pk2(y[4], y[5]); o.w = pk2(y[6], y[7]);
                *(GAS v4u*)(Y + (size_t)(rstart + dr) * DM + 512 + c0) = o;
            }
        }
        __syncthreads();
        for (int g = 0; g < 4; ++g) {
            {
                const int j = tid >> 2, part = tid & 3; const float mean = stat[2 * j], rstd = stat[2 * j + 1];
#pragma unroll
                for (int q4 = 0; q4 < 4; ++q4) {
                    const int cbase = 32 * part + 8 * q4;
                    const v4u pk = *(const GAS v4u*)(H + (size_t)(t0 + j) * MIXIN + 512 + 128 * g + cbase);
                    float v[8] = {bflo(pk.x), bfhi(pk.x), bflo(pk.y), bfhi(pk.y), bflo(pk.z), bfhi(pk.z), bflo(pk.w), bfhi(pk.w)};
#pragma unroll
                    for (int e = 0; e < 8; ++e) { const int c = cbase + e; const float val = (v[e] - mean) * rstd * lng[128 * g + c] + lnb[128 * g + c];
                        *(LAS unsigned short*)(VnT + c * 272 + j * 2) = (unsigned short)f2bf(val); }
                }
                const int i = tid >> 2, jb = (tid & 3) * 32;
                const float* wrow = wsp + ((size_t)g * 128 + i) * 128 + jb;
#pragma unroll
                for (int q4 = 0; q4 < 4; ++q4) {
                    const f32x4 a = *(const GAS f32x4*)(wrow + 8 * q4), b = *(const GAS f32x4*)(wrow + 8 * q4 + 4);
                    float w[8] = {a.x, a.y, a.z, a.w, b.x, b.y, b.z, b.w};
#pragma unroll
                    for (int e = 0; e < 8; ++e) w[e] = (jb + 8 * q4 + e <= i) ? w[e] : 0.f;
                    v4u o; o.x = pk2(w[0], w[1]); o.y = pk2(w[2], w[3]); o.z = pk2(w[4], w[5]); o.w = pk2(w[6], w[7]);
                    *(LAS v4u*)(WsL + i * 272 + (jb + 8 * q4) * 2) = o;
                }
            }
            __syncthreads();
            {
                const int it = wave >> 1, cts = 2 * (wave & 1), r32 = lane & 31, hl = lane >> 5;
                f32x16 acc0, acc1;
#pragma unroll
                for (int e = 0; e < 16; ++e) { acc0[e] = 0.f; acc1[e] = 0.f; }
                const int nks = 2 * (it + 1);
                for (int ks = 0; ks < nks; ++ks) {
                    const bf16x8 b = *(const LAS bf16x8*)(WsL + (32 * it + r32) * 272 + (16 * ks + 8 * hl) * 2);
                    const bf16x8 a0 = *(const LAS bf16x8*)(VnT + (32 * cts + r32) * 272 + (16 * ks + 8 * hl) * 2);
                    const bf16x8 a1 = *(const LAS bf16x8*)(VnT + (32 * (cts + 1) + r32) * 272 + (16 * ks + 8 * hl) * 2);
                    acc0 = __builtin_amdgcn_mfma_f32_32x32x16_bf16(a0, b, acc0, 0, 0, 0);
                    acc1 = __builtin_amdgcn_mfma_f32_32x32x16_bf16(a1, b, acc1, 0, 0, 0);
                }
                const int i = 32 * it + r32; const size_t row = (size_t)(t0 + i); const float bs = bsp[g * 128 + i];
#pragma unroll
                for (int ct2 = 0; ct2 < 2; ++ct2)
#pragma unroll
                    for (int q = 0; q < 4; ++q) {
                        const int c0 = 32 * (cts + ct2) + 8 * q + 4 * hl;
                        const v2u up = *(const GAS v2u*)(H + row * MIXIN + 128 * g + c0);
                        const float a0_ = ct2 ? acc1[4 * q + 0] : acc0[4 * q + 0], a1_ = ct2 ? acc1[4 * q + 1] : acc0[4 * q + 1], a2_ = ct2 ? acc1[4 * q + 2] : acc0[4 * q + 2], a3_ = ct2 ? acc1[4 * q + 3] : acc0[4 * q + 3];
                        v2u o; o.x = pk2(bflo(up.x) * (a0_ + bs), bfhi(up.x) * (a1_ + bs)); o.y = pk2(bflo(up.y) * (a2_ + bs), bfhi(up.y) * (a3_ + bs));
                        *(GAS v2u*)(Y + row * DM + 128 * g + c0) = o;
                    }
            }
            __syncthreads();
        }
    }
}

__device__ __forceinline__ void phase_attn(ArgsCP A, Frame F, int li) {
    FRAME_REFRESH(F);
    const bf16* Q = (const bf16*)(A->ws + WS_QB); const bf16* Kb = (const bf16*)(A->ws + WS_KB); const bf16* Vt = (const bf16*)(A->ws + WS_VT); bf16* Y = (bf16*)(A->ws + WS_Y);
    LAS unsigned char* Ks = F.lds;
    LAS unsigned char* Vs = F.lds + 36864;
    LAS float* bias = (LAS float*)(F.lds + 36864 + 33792);
    const int lane = F.lane, wave = F.wave, tid = F.tid;
    for (int idx = tid; idx < 2048; idx += 512) { const int h = idx >> 7, rel = idx & 127; bias[idx] = A->rel_table[(int)T5_BUCKET[rel] * 16 + h]; }
    const float* sinks = A->attn_sinks + li * 16;
    for (int u = F.bid; u < 512; u += F.G) {
        const int kvh = u & 1, nb = (u >> 1) & 127, b = u >> 8;
        __syncthreads();
#pragma unroll
        for (int q = 0; q < 4; ++q) {
            const int idx = tid + 512 * q;
            { const int c = idx >> 3, part = idx & 7; v4u val = (v4u){0u, 0u, 0u, 0u};
              if (nb > 0 || c >= 128) val = *(const GAS v4u*)(Kb + ((size_t)b * SEQ + (size_t)((nb - 1) * 128 + c)) * 128 + kvh * 64 + part * 8);
              *(LAS v4u*)(Ks + c * 144 + part * 16) = val; }
            { const int d = idx >> 5, part = idx & 31; v4u val = (v4u){0u, 0u, 0u, 0u};
              if (nb > 0 || part >= 16) val = *(const GAS v4u*)(Vt + ((size_t)((b * 2 + kvh) * 64 + d)) * SEQ + (nb - 1) * 128 + part * 8);
              *(LAS v4u*)(Vs + d * 528 + part * 16) = val; }
        }
        __syncthreads();
        const int hh = kvh * 8 + wave, r32 = lane & 31, hl = lane >> 5; const float sink = sinks[hh];
        for (int sb = 0; sb < 4; ++sb) {
            const int a0 = 32 * sb; const size_t qrow = (size_t)b * SEQ + nb * 128 + a0 + r32;
            bf16x8 qf[4];
#pragma unroll
            for (int ks = 0; ks < 4; ++ks) qf[ks] = *(const GAS bf16x8*)(Q + qrow * DM + hh * 64 + 16 * ks + 8 * hl);
            f32x16 S[5];
#pragma unroll
            for (int k5 = 0; k5 < 5; ++k5) {
#pragma unroll
                for (int e = 0; e < 16; ++e) S[k5][e] = 0.f;
#pragma unroll
                for (int ks = 0; ks < 4; ++ks) { const bf16x8 a = *(const LAS bf16x8*)(Ks + (32 * (sb + k5) + r32) * 144 + (16 * ks + 8 * hl) * 2);
                    S[k5] = __builtin_amdgcn_mfma_f32_32x32x16_bf16(a, qf[ks], S[k5], 0, 0, 0); }
            }
            const int a = a0 + r32; float mx = sink;
#pragma unroll
            for (int k5 = 0; k5 < 5; ++k5)
#pragma unroll
                for (int e = 0; e < 16; ++e) { const int c = 32 * (sb + k5) + (e & 3) + 8 * (e >> 2) + 4 * hl; const int rel = a + 128 - c;
                    const bool valid = (rel >= 0) && (rel < 128) && (nb > 0 || c >= 128);
                    const float sc = valid ? S[k5][e] + bias[hh * 128 + (rel & 127)] : -1e30f; S[k5][e] = sc; mx = fmaxf(mx, sc); }
            mx = fmaxf(mx, __shfl_xor(mx, 32));
            float sum = 0.f;
#pragma unroll
            for (int k5 = 0; k5 < 5; ++k5)
#pragma unroll
                for (int e = 0; e < 16; ++e) { const float p = __expf(S[k5][e] - mx); S[k5][e] = p; sum += p; }
            sum += __shfl_xor(sum, 32);
            const float inv = 1.f / (sum + __expf(sink - mx));
            f32x16 O0, O1;
#pragma unroll
            for (int e = 0; e < 16; ++e) { O0[e] = 0.f; O1[e] = 0.f; }
#pragma unroll
            for (int k5 = 0; k5 < 5; ++k5)
#pragma unroll
                for (int s = 0; s < 2; ++s) {
                    v4u pw; pw.x = pk2(S[k5][8 * s + 0], S[k5][8 * s + 1]); pw.y = pk2(S[k5][8 * s + 2], S[k5][8 * s + 3]); pw.z = pk2(S[k5][8 * s + 4], S[k5][8 * s + 5]); pw.w = pk2(S[k5][8 * s + 6], S[k5][8 * s + 7]);
                    const bf16x8 pf = __builtin_bit_cast(bf16x8, pw);
                    const int kc = 32 * (sb + k5) + 16 * s + 4 * hl;
                    { const v2u lo = *(const LAS v2u*)(Vs + r32 * 528 + kc * 2), hi = *(const LAS v2u*)(Vs + r32 * 528 + (kc + 8) * 2);
                      const v4u av = (v4u){lo.x, lo.y, hi.x, hi.y}; O0 = __builtin_amdgcn_mfma_f32_32x32x16_bf16(__builtin_bit_cast(bf16x8, av), pf, O0, 0, 0, 0); }
                    { const v2u lo = *(const LAS v2u*)(Vs + (32 + r32) * 528 + kc * 2), hi = *(const LAS v2u*)(Vs + (32 + r32) * 528 + (kc + 8) * 2);
                      const v4u av = (v4u){lo.x, lo.y, hi.x, hi.y}; O1 = __builtin_amdgcn_mfma_f32_32x32x16_bf16(__builtin_bit_cast(bf16x8, av), pf, O1, 0, 0, 0); }
                }
            bf16* orow = Y + qrow * DM + hh * 64;
#pragma unroll
            for (int qd = 0; qd < 4; ++qd) {
                const int d0 = 8 * qd + 4 * hl;
                v2u o0; o0.x = pk2(O0[4 * qd + 0] * inv, O0[4 * qd + 1] * inv); o0.y = pk2(O0[4 * qd + 2] * inv, O0[4 * qd + 3] * inv);
                v2u o1; o1.x = pk2(O1[4 * qd + 0] * inv, O1[4 * qd + 1] * inv); o1.y = pk2(O1[4 * qd + 2] * inv, O1[4 * qd + 3] * inv);
                *(GAS v2u*)(orow + d0) = o0; *(GAS v2u*)(orow + 32 + d0) = o1;
            }
        }
    }
    __syncthreads();
}

__device__ __forceinline__ void unpack8(const v4u p, float (&v)[8]) { v[0] = bflo(p.x); v[1] = bfhi(p.x); v[2] = bflo(p.y); v[3] = bfhi(p.y); v[4] = bflo(p.z); v[5] = bfhi(p.z); v[6] = bflo(p.w); v[7] = bfhi(p.w); }
__device__ __forceinline__ void phase_ln1(ArgsCP A, Frame F, int l) {
    FRAME_REFRESH(F);
    const bf16* R = (const bf16*)(A->ws + WS_H); bf16* XB = (bf16*)(A->ws + WS_XB);
    const float* g = A->ln1_g + l * DM; const float* bb = A->ln1_b + l * DM;
    const bf16* RH = (const bf16*)(A->ws + WS_RTR) + (size_t)(l * 2 + 0) * 48 * 1024; const bf16* RL = (const bf16*)(A->ws + WS_RTR) + (size_t)(l * 2 + 1) * 48 * 1024;
    unsigned* cnt = (unsigned*)(A->ws + WS_CTL) + CW_CNT + l * 32;
    unsigned* ltok = (unsigned*)(A->ws + WS_LTOK); float* lgate = (float*)(A->ws + WS_LGATE);
    LAS unsigned char* XH = F.lds; LAS unsigned char* PS = F.lds + 66048;
    LAS float* LG = (LAS float*)(F.lds + 90624); LAS int* ASGE = (LAS int*)(F.lds + 93696); LAS float* ASGG = (LAS float*)(F.lds + 94720);
    LAS int* LCNT = (LAS int*)(F.lds + 95744); LAS int* LBASE = (LAS int*)(F.lds + 95872); LAS int* RANK = (LAS int*)(F.lds + 96000);
    const int lane = F.lane, wave = F.wave, tid = F.tid;
    bf16x8 BH[3][4], BL[3][4];
#pragma unroll
    for (int nt = 0; nt < 3; ++nt)
#pragma unroll
        for (int ksl = 0; ksl < 4; ++ksl) { const size_t off = (size_t)(16 * nt + (lane & 15)) * 1024 + 32 * (4 * wave + ksl) + 8 * (lane >> 4);
            BH[nt][ksl] = *(const GAS bf16x8*)(RH + off); BL[nt][ksl] = *(const GAS bf16x8*)(RL + off); }
    float gv[2][8], bv[2][8];
#pragma unroll
    for (int j = 0; j < 2; ++j)
#pragma unroll
        for (int h = 0; h < 2; ++h) { const f32x4 a = *(const GAS f32x4*)(g + 8 * lane + 512 * j + 4 * h), b = *(const GAS f32x4*)(bb + 8 * lane + 512 * j + 4 * h);
#pragma unroll
            for (int e = 0; e < 4; ++e) { gv[j][4 * h + e] = a[e]; bv[j][4 * h + e] = b[e]; } }
    for (int rb = F.bid; rb < T_TOK / 128; rb += F.G) {
        const int rowbase = rb * 128;
        if (tid < 32) LCNT[tid] = 0;
        for (int tt = 0; tt < 8; ++tt) {
#pragma unroll
            for (int rr = 0; rr < 2; ++rr) {
                const int rl = 2 * wave + rr; const size_t row = (size_t)(rowbase + 16 * tt + rl);
                float v[2][8]; float s = 0.f;
#pragma unroll
                for (int j = 0; j < 2; ++j) { unpack8(*(const GAS v4u*)(R + row * DM + 8 * lane + 512 * j), v[j]);
#pragma unroll
                    for (int e = 0; e < 8; ++e) s += v[j][e]; }
                const float mean = wave_sum(s) * (1.f / DM); float s2 = 0.f;
#pragma unroll
                for (int j = 0; j < 2; ++j)
#pragma unroll
                    for (int e = 0; e < 8; ++e) { v[j][e] -= mean; s2 += v[j][e] * v[j][e]; }
                const float rstd = 1.f / sqrtf(wave_sum(s2) * (1.f / DM) + LN_EPS);
#pragma unroll
                for (int j = 0; j < 2; ++j) {
                    float xn[8];
#pragma unroll
                    for (int e = 0; e < 8; ++e) xn[e] = v[j][e] * rstd * gv[j][e] + bv[j][e];
                    v4u hw; hw.x = pk2(xn[0], xn[1]); hw.y = pk2(xn[2], xn[3]); hw.z = pk2(xn[4], xn[5]); hw.w = pk2(xn[6], xn[7]);
                    *(GAS v4u*)(XB + row * DM + 8 * lane + 512 * j) = hw;
                    *(LAS v4u*)(XH + rl * 2064 + (8 * lane + 512 * j) * 2) = hw;
                }
            }
            __syncthreads();
            {
                f32x4 acc[3];
#pragma unroll
                for (int nt = 0; nt < 3; ++nt) acc[nt] = (f32x4){0.f, 0.f, 0.f, 0.f};
#pragma unroll
                for (int ksl = 0; ksl < 4; ++ksl) {
                    const int k0 = 32 * (4 * wave + ksl) + 8 * (lane >> 4);
                    const bf16x8 ah = *(const LAS bf16x8*)(XH + (lane & 15) * 2064 + k0 * 2);
#pragma unroll
                    for (int nt = 0; nt < 3; ++nt) {
                        acc[nt] = __builtin_amdgcn_mfma_f32_16x16x32_bf16(ah, BH[nt][ksl], acc[nt], 0, 0, 0);
                        acc[nt] = __builtin_amdgcn_mfma_f32_16x16x32_bf16(ah, BL[nt][ksl], acc[nt], 0, 0, 0);
                    }
                }
#pragma unroll
                for (int nt = 0; nt < 3; ++nt) *(LAS f32x4*)(PS + ((wave * 3 + nt) * 64 + lane) * 16) = acc[nt];
            }
            __syncthreads();
            if (tid < 192) {
                const int nt = tid >> 6, ln = tid & 63; f32x4 s = (f32x4){0.f, 0.f, 0.f, 0.f};
#pragma unroll
                for (int w = 0; w < 8; ++w) s += *(const LAS f32x4*)(PS + ((w * 3 + nt) * 64 + ln) * 16);
#pragma unroll
                for (int r = 0; r < 4; ++r) LG[(4 * (ln >> 4) + r) * 48 + 16 * nt + (ln & 15)] = s[r];
            }
            __syncthreads();
            if (tid < 16) {
                const LAS float* lg = LG + tid * 48;
                int gi = 0; float gm = lg[0];
#pragma unroll
                for (int j = 1; j < 4; ++j) { const float v = lg[j]; if (v > gm) { gm = v; gi = j; } }
                float gs = 0.f;
#pragma unroll
                for (int j = 0; j < 4; ++j) gs += __expf(lg[j] - gm);
                const float gp = 1.f / gs;
                float el[8];
#pragma unroll
                for (int j = 0; j < 8; ++j) el[j] = lg[4 + 8 * gi + j];
                int i1 = 0; float m1 = el[0];
#pragma unroll
                for (int j = 1; j < 8; ++j) if (el[j] > m1) { m1 = el[j]; i1 = j; }
                int i2 = -1; float m2 = -3.0e38f;
#pragma unroll
                for (int j = 0; j < 8; ++j) if (j != i1 && el[j] > m2) { m2 = el[j]; i2 = j; }
                const float e21 = __expf(m2 - m1); const float p1 = 1.f / (1.f + e21), p2 = e21 * p1;
                const int a0 = (16 * tt + tid) * 2;
                ASGE[a0] = 8 * gi + i1; ASGG[a0] = gp * p1; ASGE[a0 + 1] = 8 * gi + i2; ASGG[a0 + 1] = gp * p2;
            }
        }
        __syncthreads();
        if (tid < 256) RANK[tid] = __hip_atomic_fetch_add(&LCNT[ASGE[tid]], 1, __ATOMIC_RELAXED, __HIP_MEMORY_SCOPE_WORKGROUP);
        __syncthreads();
        if (tid < 32) LBASE[tid] = (int)__hip_atomic_fetch_add(cnt + tid, (unsigned)LCNT[tid], __ATOMIC_RELAXED, __HIP_MEMORY_SCOPE_AGENT);
        __syncthreads();
        if (tid < 256) { const int e = ASGE[tid]; const int slot = LBASE[e] + RANK[tid];
            ltok[(size_t)e * T_TOK + slot] = (unsigned)(rowbase + (tid >> 1)) | ((unsigned)(tid & 1) << 31); lgate[(size_t)e * T_TOK + slot] = ASGG[tid]; }
        __syncthreads();
    }
}

__device__ __forceinline__ void phase_ln2(ArgsCP A, Frame F, int l) {
    FRAME_REFRESH(F);
    float* xout = A->out; bf16* XB = (bf16*)(A->ws + WS_XB); const bf16* YB = (const bf16*)(A->ws + WS_H);
    const float* g = A->ln2_g + l * DM; const float* bb = A->ln2_b + l * DM;
    const int lane = F.lane; const int gw = F.bid * 8 + F.wave, NGW = F.G * 8;
    const bool last = (l == NLAYER - 1);
    float gv[2][8], bv[2][8];
#pragma unroll
    for (int j = 0; j < 2; ++j)
#pragma unroll
        for (int h = 0; h < 2; ++h) { const f32x4 a = *(const GAS f32x4*)(g + 8 * lane + 512 * j + 4 * h), b = *(const GAS f32x4*)(bb + 8 * lane + 512 * j + 4 * h);
#pragma unroll
            for (int e = 0; e < 4; ++e) { gv[j][4 * h + e] = a[e]; bv[j][4 * h + e] = b[e]; } }
    for (int m = gw; m < T_TOK; m += NGW) {
        const size_t row = (size_t)m;
        float v[2][8]; float s = 0.f;
#pragma unroll
        for (int j = 0; j < 2; ++j) {
            float xv[8], y0[8], y1[8];
            unpack8(*(const GAS v4u*)(XB + row * DM + 8 * lane + 512 * j), xv);
            unpack8(*(const GAS v4u*)(YB + row * DM + 8 * lane + 512 * j), y0);
            unpack8(*(const GAS v4u*)(YB + ((size_t)T_TOK + row) * DM + 8 * lane + 512 * j), y1);
#pragma unroll
            for (int e = 0; e < 8; ++e) { v[j][e] = xv[e] * ALPHA + (y0[e] + y1[e]); s += v[j][e]; }
        }
        const float mean = wave_sum(s) * (1.f / DM); float s2 = 0.f;
#pragma unroll
        for (int j = 0; j < 2; ++j)
#pragma unroll
            for (int e = 0; e < 8; ++e) { v[j][e] -= mean; s2 += v[j][e] * v[j][e]; }
        const float rstd = 1.f / sqrtf(wave_sum(s2) * (1.f / DM) + LN_EPS);
#pragma unroll
        for (int j = 0; j < 2; ++j) {
            float xn[8];
#pragma unroll
            for (int e = 0; e < 8; ++e) xn[e] = v[j][e] * rstd * gv[j][e] + bv[j][e];
            if (last) {
                *(GAS f32x4*)(xout + row * DM + 8 * lane + 512 * j) = (f32x4){xn[0], xn[1], xn[2], xn[3]};
                *(GAS f32x4*)(xout + row * DM + 8 * lane + 512 * j + 4) = (f32x4){xn[4], xn[5], xn[6], xn[7]};
            } else {
                v4u hw; hw.x = pk2(xn[0], xn[1]); hw.y = pk2(xn[2], xn[3]); hw.z = pk2(xn[4], xn[5]); hw.w = pk2(xn[6], xn[7]);
                *(GAS v4u*)(XB + row * DM + 8 * lane + 512 * j) = hw;
            }
        }
    }
}

__global__ void __launch_bounds__(512, 2) hybrid_fwd(Args A_unused) {
    extern __shared__ __attribute__((aligned(16))) unsigned char lds_raw[];
    Frame F;
    F.lds = (LAS unsigned char*)lds_raw;
    F.tid = threadIdx.x; F.lane = F.tid & 63; F.wave = __builtin_amdgcn_readfirstlane(F.tid >> 6); F.G = gridDim.x; F.bid = blockIdx.x;
    volatile LAS unsigned* MISC = (volatile LAS unsigned*)(F.lds + MISC_OFF);
    for (int u = F.tid; u < (LDS_BYTES - TAB_OFF) / 4; u += 512) ((LAS unsigned*)(F.lds + TAB_OFF))[u] = 0u;
    __syncthreads();
    XcdBarrier bar;
    { ArgsCP A = ARGS_PTR(); bar = xcd_barrier_post((unsigned*)(A->ws + WS_CTL) + CW_BAR, MISC + 8); }
    LAS unsigned* tab = (LAS unsigned*)(F.lds + TAB_OFF);
    LAS int* bst = (LAS int*)(F.lds + BST_OFF);

#if PH_P0
    for (int rep_ = 0; rep_ < REP_P0; ++rep_) { if (rep_) xcd_barrier(bar); phase_prologue(ARGS_PTR(), F); }
#endif
    xcd_barrier(bar);

    for (int l = 0; l < NLAYER; ++l) {
        const int li = l >> 1;
        if ((l & 1) == 0) {
            {
                ArgsCP A = ARGS_PTR();
                pg8::Gemm g{(const bf16*)(A->ws + WS_XB), (const bf16*)(A->ws + WS_WIN) + (size_t)li * MIXIN * DM, 0, nullptr};
                pg8::StaticOrder S; S.init(T_TOK, MIXIN, F.G, F.bid);
                pg8::EpiH E{(bf16*)(A->ws + WS_H)};
#if PH_E1
                for (int rep_ = 0; rep_ < REP_E1; ++rep_) { if (rep_) xcd_barrier(bar); pg8::gemm_phase<pg8::EpiH, pg8::StaticOrder, false, DM>(F.lds, tab, g, S, E); }
#endif
            }
            xcd_barrier(bar);
#if PH_E2
            for (int rep_ = 0; rep_ < REP_E2; ++rep_) { if (rep_) xcd_barrier(bar); phase_gmlp(ARGS_PTR(), F, li); }
#endif
            xcd_barrier(bar);
            {
                ArgsCP A = ARGS_PTR();
                pg8::Gemm g{(const bf16*)(A->ws + WS_Y), (const bf16*)(A->ws + WS_WOUT) + (size_t)li * DM * DM, 0, nullptr};
                pg8::StaticOrder S; S.init(T_TOK, DM, F.G, F.bid);
                pg8::EpiRes E{(const bf16*)(A->ws + WS_XB), (bf16*)(A->ws + WS_H), nullptr};
#if PH_E3
                for (int rep_ = 0; rep_ < REP_E3; ++rep_) { if (rep_) xcd_barrier(bar); pg8::gemm_phase<pg8::EpiRes, pg8::StaticOrder, false, DM>(F.lds, tab, g, S, E); }
#endif
            }
            xcd_barrier(bar);
        } else {
            {
                ArgsCP A = ARGS_PTR();
                pg8::Gemm g{(const bf16*)(A->ws + WS_XB), (const bf16*)(A->ws + WS_WQKV) + (size_t)li * QKVD * DM, 0, nullptr};
                pg8::StaticOrder S; S.init(T_TOK, QKVD, F.G, F.bid);
                pg8::EpiQKV E{(bf16*)(A->ws + WS_QB), (bf16*)(A->ws + WS_KB), (bf16*)(A->ws + WS_VT), A->attn_b_qkv + li * QKVD};
#if PH_A1
                for (int rep_ = 0; rep_ < REP_A1; ++rep_) { if (rep_) xcd_barrier(bar); pg8::gemm_phase<pg8::EpiQKV, pg8::StaticOrder, false, DM>(F.lds, tab, g, S, E); }
#endif
            }
            xcd_barrier(bar);
#if PH_A2
            for (int rep_ = 0; rep_ < REP_A2; ++rep_) { if (rep_) xcd_barrier(bar); phase_attn(ARGS_PTR(), F, li); }
#endif
            xcd_barrier(bar);
            {
                ArgsCP A = ARGS_PTR();
                pg8::Gemm g{(const bf16*)(A->ws + WS_Y), (const bf16*)(A->ws + WS_WO) + (size_t)li * DM * DM, 0, nullptr};
                pg8::StaticOrder S; S.init(T_TOK, DM, F.G, F.bid);
                pg8::EpiRes E{(const bf16*)(A->ws + WS_XB), (bf16*)(A->ws + WS_H), A->attn_b_o + li * DM};
#if PH_A3
                for (int rep_ = 0; rep_ < REP_A3; ++rep_) { if (rep_) xcd_barrier(bar); pg8::gemm_phase<pg8::EpiRes, pg8::StaticOrder, false, DM>(F.lds, tab, g, S, E); }
#endif
            }
            xcd_barrier(bar);
        }
#if PH_L1
        phase_ln1(ARGS_PTR(), F, l);
#endif
        xcd_barrier(bar);
        {
            ArgsCP A = ARGS_PTR();
            unsigned* ctl = (unsigned*)(A->ws + WS_CTL);
            const int tid = threadIdx.x;
            if (tid < 32) { const int c = (int)__hip_atomic_load(ctl + CW_CNT + l * 32 + tid, __ATOMIC_RELAXED, __HIP_MEMORY_SCOPE_AGENT); bst[64 + tid] = c; bst[96 + tid] = (c + 255) >> 8; }
            __syncthreads();
            if (tid == 0) { int s = 0; for (int e = 0; e < 32; ++e) { bst[e] = s; s += bst[96 + e]; } bst[32] = s; }
            __syncthreads();
        }
        {
            ArgsCP A = ARGS_PTR();
            const int total = __builtin_amdgcn_readfirstlane(bst[32]);
            pg8::Gemm g{(const bf16*)(A->ws + WS_XB), (const bf16*)(A->ws + WS_W1) + (size_t)l * NEXP * DM * DM, (size_t)DM * DM * 2, (const unsigned*)(A->ws + WS_LTOK)};
            pg8::MoeOrder S{bst, total, F.G, F.bid};
            pg8::EpiHid E{(bf16*)(A->ws + WS_HID)};
#if PH_M1
            for (int rep_ = 0; rep_ < REP_M1; ++rep_) { if (rep_) xcd_barrier(bar); pg8::gemm_phase<pg8::EpiHid, pg8::MoeOrder, true, DM>(F.lds, tab, g, S, E); }
#endif
        }
        xcd_barrier(bar);
        {
            ArgsCP A = ARGS_PTR();
            const int total = __builtin_amdgcn_readfirstlane(bst[32]);
            pg8::Gemm g{(const bf16*)(A->ws + WS_HID), (const bf16*)(A->ws + WS_W2) + (size_t)l * NEXP * DM * DEXP, (size_t)DM * DEXP * 2, nullptr};
            pg8::MoeOrder S{bst, total, F.G, F.bid};
            pg8::EpiScatter E{(bf16*)(A->ws + WS_H), (const unsigned*)(A->ws + WS_LTOK), (const float*)(A->ws + WS_LGATE)};
#if PH_M2
            for (int rep_ = 0; rep_ < REP_M2; ++rep_) { if (rep_) xcd_barrier(bar); pg8::gemm_phase<pg8::EpiScatter, pg8::MoeOrder, false, DEXP>(F.lds, tab, g, S, E); }
#endif
        }
        xcd_barrier(bar);
#if PH_L2
        phase_ln2(ARGS_PTR(), F, l);
#endif
        if (l + 1 < NLAYER) xcd_barrier(bar);
    }
}

extern "C" void kernel_launch(void* const* d_in, const int* in_sizes, int n_in, void* d_out, int out_size, void* d_ws, size_t ws_size, hipStream_t stream) {
    static int grid = 0;
    if (grid == 0) {
        if (n_in != 23 || out_size != T_TOK * DM || ws_size < WS_END) { fprintf(stderr, "kernel_launch: unexpected shapes (n_in %d, out %d, ws %zu, need %zu)\n", n_in, out_size, ws_size, (size_t)WS_END); grid = -1; return; }
        int dev = 0, cus = 0, per_cu = 0;
        if (hipGetDevice(&dev) != hipSuccess || hipDeviceGetAttribute(&cus, hipDeviceAttributeMultiprocessorCount, dev) != hipSuccess) { grid = -1; return; }
        if (hipFuncSetAttribute((const void*)hybrid_fwd, hipFuncAttributeMaxDynamicSharedMemorySize, LDS_BYTES) != hipSuccess) { fprintf(stderr, "kernel_launch: hipFuncSetAttribute failed\n"); grid = -1; return; }
        if (hipOccupancyMaxActiveBlocksPerMultiprocessor(&per_cu, (const void*)hybrid_fwd, 512, LDS_BYTES) != hipSuccess || per_cu < 1) fprintf(stderr, "kernel_launch: occupancy query reports %d\n", per_cu);
        (void)hipGetLastError();
        grid = cus;
    }
    if (grid < 0) return;
    if (hipMemsetAsync((char*)d_ws + WS_CTL, 0, CTL_ZERO_BYTES, stream) != hipSuccess) return;
    Args a{};
    const float** p = (const float**)&a;
    for (int i = 0; i < 23; ++i) p[i] = (const float*)d_in[i];
    a.out = (float*)d_out; a.ws = (unsigned char*)d_ws;
    hipLaunchKernelGGL(hybrid_fwd, dim3(grid), dim3(512), LDS_BYTES, stream, a);
}
```
